# Optimizing an MI355X kernel written in HIP

```python
import jax, jax.numpy as jnp
from jax import lax
import numpy as np

D_MODEL = 1024
BATCH = 4
SEQ = 4096
DEPTH = 2

D_MIX = D_MODEL
D_A = D_MIX // 2
D_B = D_MIX - D_A
A_GROUPS = 4
A_GROUP_DIM = D_A // A_GROUPS
A_CHUNK = 128
B_HEADS = 4
B_HEAD_DIM = D_B // B_HEADS
B_CHUNK = 64
D_IN = 2 * D_A + 4 * D_B
D_FF = 4 * D_MODEL
EPS = 1e-6

kernel_name = "hybrid_gmlp_hgrn2_parallel_heads"


def rms_norm(x, w):
    x32 = x.astype(jnp.float32)
    y = x32 * lax.rsqrt(jnp.mean(jnp.square(x32), axis=-1, keepdims=True) + EPS)
    return (y * w.astype(jnp.float32)).astype(x.dtype)


def group_rms_norm(x, w, groups):
    lead = x.shape[:-1]
    x32 = x.astype(jnp.float32).reshape(*lead, groups, -1)
    y = x32 * lax.rsqrt(jnp.mean(jnp.square(x32), axis=-1, keepdims=True) + EPS)
    y = y.reshape(*lead, -1) * w.astype(jnp.float32)
    return y.astype(x.dtype)


def gmlp_chunk_mixer(u, v, w_s, b_s, g_v, g_out):
    bsz, seq, _ = u.shape
    n_chunks = seq // A_CHUNK
    v = group_rms_norm(v, g_v, A_GROUPS)
    v = v.reshape(bsz, n_chunks, A_CHUNK, A_GROUPS, A_GROUP_DIM)
    w_causal = w_s * jnp.tril(jnp.ones((A_CHUNK, A_CHUNK), w_s.dtype))
    mixed = jnp.einsum('gts,bnsgc->bntgc', w_causal, v) + b_s.T[:, :, None]
    y = u * mixed.reshape(bsz, seq, D_A)
    return group_rms_norm(y, g_out, A_GROUPS)


def hgrn2_chunkwise(q, k, v, log_f):
    bsz, seq, heads, dk = q.shape
    dv = v.shape[-1]
    n_chunks = seq // B_CHUNK

    def to_chunks(t):
        return t.reshape(bsz, n_chunks, B_CHUNK, heads, t.shape[-1]).transpose(1, 0, 3, 2, 4)

    qc, kc, vc, gc = (to_chunks(t) for t in (q, k, v, log_f))
    bc = jnp.cumsum(gc, axis=-2)
    causal = jnp.tril(jnp.ones((B_CHUNK, B_CHUNK), bool))[:, :, None]

    def step(state, inp):
        qb, kb, vb, bb = inp
        diff = bb[:, :, :, None, :] - bb[:, :, None, :, :]
        decay = jnp.exp(jnp.where(causal, diff, -jnp.inf))
        scores = jnp.einsum('bhtk,bhsk,bhtsk->bhts', qb, kb, decay)
        o_intra = jnp.einsum('bhts,bhsv->bhtv', scores, vb)
        o_inter = jnp.einsum('bhtk,bhkv->bhtv', qb * jnp.exp(bb), state)
        b_last = bb[:, :, -1, :]
        new_state = state * jnp.exp(b_last)[..., None] + jnp.einsum(
            'bhsk,bhsv->bhkv', kb * jnp.exp(b_last[:, :, None, :] - bb), vb)
        return new_state, o_intra + o_inter

    state0 = jnp.zeros((bsz, heads, dk, dv), jnp.float32)
    _, out = lax.scan(step, state0, (qc, kc, vc, bc))
    return out.transpose(1, 0, 3, 2, 4).reshape(bsz, seq, heads * dv)


def hybrid_mixer(h, w_in, w_s, b_s, g_v, g_a_out, lb, g_b_out, w_out):
    bsz, seq, _ = h.shape
    z = h @ w_in
    za_u, za_v, zq, zf, zi, zg = jnp.split(
        z, [D_A, 2 * D_A, 2 * D_A + D_B, 2 * D_A + 2 * D_B, 2 * D_A + 3 * D_B], axis=-1)

    y_a = gmlp_chunk_mixer(jax.nn.gelu(za_u), jax.nn.gelu(za_v), w_s, b_s, g_v, g_a_out)

    z32 = zf.astype(jnp.float32)
    lb32 = lb.astype(jnp.float32)
    log_f = jnp.logaddexp(jnp.log(lb32), jnp.log1p(-lb32) + jax.nn.log_sigmoid(z32))
    k = (1.0 - lb32) * jax.nn.sigmoid(-z32)
    shp = (bsz, seq, B_HEADS, B_HEAD_DIM)
    o_b = hgrn2_chunkwise(zq.astype(jnp.float32).reshape(shp), k.reshape(shp),
                          zi.astype(jnp.float32).reshape(shp), log_f.reshape(shp))
    y_b = group_rms_norm(o_b.astype(h.dtype), g_b_out, B_HEADS) * jax.nn.silu(zg)

    return jnp.concatenate([y_a, y_b], axis=-1) @ w_out


def sqrelu_mlp(h, w_up, w_down):
    return jnp.square(jax.nn.relu(h @ w_up)) @ w_down


def setup_inputs(seed: int = 0) -> dict:
    key = jax.random.key(seed)
    ks = jax.random.split(key, 16)
    nrm = jax.random.normal
    f32 = jnp.float32
    return {
        "x": nrm(ks[0], (BATCH, SEQ, D_MODEL), f32),
        "norm_mix": 1.0 + 0.02 * nrm(ks[1], (DEPTH, D_MODEL), f32),
        "w_in": nrm(ks[2], (DEPTH, D_MODEL, D_IN), f32) * D_MODEL ** -0.5,
        "spatial_w": nrm(ks[3], (DEPTH, A_GROUPS, A_CHUNK, A_CHUNK), f32) * A_CHUNK ** -0.5,
        "spatial_b": 1.0 + 0.1 * nrm(ks[4], (DEPTH, A_GROUPS, A_CHUNK), f32),
        "norm_v": 1.0 + 0.02 * nrm(ks[5], (DEPTH, D_A), f32),
        "norm_a_out": 1.0 + 0.02 * nrm(ks[6], (DEPTH, D_A), f32),
        "lower_bounds": 0.5 * nrm(ks[7], (DEPTH, D_B), f32),
        "norm_b_out": 1.0 + 0.02 * nrm(ks[8], (DEPTH, D_B), f32),
        "w_out": nrm(ks[9], (DEPTH, D_MIX, D_MODEL), f32) * D_MIX ** -0.5,
        "norm_mlp": 1.0 + 0.02 * nrm(ks[10], (DEPTH, D_MODEL), f32),
        "w_up": nrm(ks[11], (DEPTH, D_MODEL, D_FF), f32) * D_MODEL ** -0.5,
        "w_down": nrm(ks[12], (DEPTH, D_FF, D_MODEL), f32) * D_FF ** -0.5,
        "norm_final": 1.0 + 0.02 * nrm(ks[13], (D_MODEL,), f32),
    }


def reference(x, norm_mix, w_in, spatial_w, spatial_b, norm_v, norm_a_out, lower_bounds,
              norm_b_out, w_out, norm_mlp, w_up, w_down, norm_final):
    lb_all = jnp.cumsum(jax.nn.softmax(lower_bounds.astype(jnp.float32), axis=0), axis=0)
    lb_all = lb_all - lb_all[0:1]
    for l in range(DEPTH):
        h = rms_norm(x, norm_mix[l])
        x = x + hybrid_mixer(h, w_in[l], spatial_w[l], spatial_b[l], norm_v[l], norm_a_out[l],
                             lb_all[l], norm_b_out[l], w_out[l])
        h = rms_norm(x, norm_mlp[l])
        x = x + sqrelu_mlp(h, w_up[l], w_down[l])
    return rms_norm(x, norm_final)
```

```cpp
#include <hip/hip_runtime.h>
#include <hip/hip_cooperative_groups.h>
#include <cstdio>
#include <cstdint>
namespace cg = cooperative_groups;
namespace pg8 {
#define PG8_LAS __attribute__((address_space(3)))
typedef unsigned short bf16_t;
typedef short bf16x8 __attribute__((ext_vector_type(8)));
typedef float f32x4 __attribute__((ext_vector_type(4)));
typedef unsigned u32x4 __attribute__((ext_vector_type(4)));
constexpr int BM = 256, BK = 64, HALF = 128, HTB = HALF * BK * 2  , STAGE_BYTES = 8 * HTB, NXCD = 8, WGM = 8;

__host__ __device__ __forceinline__ int lds_byte(int r, int c) { const int st = (r >> 4) * 2 + (c >> 5), rr = r & 15, cc = c & 31, ob = rr * 64 + cc * 2; return st * 1024 + (ob ^ (((ob >> 9) & 1) << 5)); }
__host__ __device__ __forceinline__ void stage_rc(int b, int& R, int& C) { const int st = b / 1024, sb = b % 1024, swz = sb ^ (((sb >> 9) & 1) << 5); R = (st >> 1) * 16 + swz / 64; C = (st & 1) * 32 + (swz % 64) / 2; }
__host__ __device__ __forceinline__ int perm32(int rho) { const int n = rho >> 4, i = rho & 15; return 8 * (i >> 2) + 4 * n + (i & 3); }

struct Unit { int pm, pn; };
struct Gemm { const bf16_t* A; const bf16_t* Bt; int M, N, K; };

struct StaticOrder {
    int nM, nN, nwg, G, c;
    __host__ __device__ void init(int M, int N, int G_, int c_) { nM = M / BM; nN = N / BM; nwg = nM * nN; G = G_; c = c_; }
    __host__ __device__ bool next(int i, Unit& u) const {
        const long L = (long)i * G + c; if (L >= nwg) return false;
        int wgid = (int)L; { const int q = nwg / NXCD, r = nwg % NXCD, xcd = wgid % NXCD, off = wgid / NXCD; wgid = (xcd < r ? xcd * (q + 1) : r * (q + 1) + (xcd - r) * q) + off; }
        const int nig = WGM * nN, gid = wgid / nig, fm = gid * WGM, gsz = (nM - fm) < WGM ? (nM - fm) : WGM;
        u.pm = fm + ((wgid % nig) % gsz); u.pn = (wgid % nig) / gsz; return true;
    }
    __device__ __forceinline__ void a_ready(const Unit&) const {}
    __device__ __forceinline__ void done(const Unit&) const {}
};


__device__ __forceinline__ unsigned cvt_pk_bf16(float lo, float hi) { unsigned r; asm volatile("v_cvt_pk_bf16_f32 %0, %1, %2" : "=v"(r) : "v"(lo), "v"(hi)); return r; }
__device__ __forceinline__ float sigmoidf_fast(float z) { return __builtin_amdgcn_rcpf(1.0f + __expf(-z)); }
__device__ __forceinline__ float gelu_tanh(float x) { const float t = 1.5957691216057308f * (x + 0.044715f * x * x * x); return x * sigmoidf_fast(t); }

struct EpiIn {
    static constexpr bool PERM = true, AFTER_DRAIN = false;
    const float* rowss; const float* lb; bf16_t* U; bf16_t* V; bf16_t* Q; float* LF; bf16_t* I; bf16_t* G;
    __device__ __forceinline__ void operator()(const f32x4 (&acc)[2][2][4][2], const Unit& u, int wr, int wc, int fr, int fq) const {
        const int type = u.pn >> 1;
        const int row0 = u.pm * BM + wr * 64 + fr, cs = (u.pn & 1) * 256 + wc * 32 + 8 * fq;
        if (type == 3) {
            f32x4 l0[2], l1[2];
#pragma unroll
            for (int bj = 0; bj < 2; ++bj) { l0[bj] = *(const f32x4*)(lb + cs + bj * HALF); l1[bj] = *(const f32x4*)(lb + cs + bj * HALF + 4); }
#pragma unroll
            for (int ai = 0; ai < 2; ++ai)
#pragma unroll
                for (int m = 0; m < 4; ++m) { const int row = row0 + ai * HALF + m * 16; const float r = rsqrtf(rowss[row] * (1.0f / 1024.0f) + 1e-6f);
#pragma unroll
                    for (int bj = 0; bj < 2; ++bj) { f32x4 v0 = acc[ai][bj][m][0] * r, v1 = acc[ai][bj][m][1] * r;
#pragma unroll
                        for (int j = 0; j < 4; ++j) { v0[j] = __logf(l0[bj][j] + (1.0f - l0[bj][j]) * sigmoidf_fast(v0[j])); v1[j] = __logf(l1[bj][j] + (1.0f - l1[bj][j]) * sigmoidf_fast(v1[j])); }
                        float* p = LF + (size_t)row * 512 + cs + bj * HALF; *(f32x4*)p = v0; *(f32x4*)(p + 4) = v1; } }
        } else {
            bf16_t* ob = type == 0 ? U : type == 1 ? V : type == 2 ? Q : type == 4 ? I : G;
#pragma unroll
            for (int ai = 0; ai < 2; ++ai)
#pragma unroll
                for (int m = 0; m < 4; ++m) { const int row = row0 + ai * HALF + m * 16; const float r = rsqrtf(rowss[row] * (1.0f / 1024.0f) + 1e-6f);
#pragma unroll
                    for (int bj = 0; bj < 2; ++bj) { f32x4 v0 = acc[ai][bj][m][0] * r, v1 = acc[ai][bj][m][1] * r;
                        if (type <= 1) {
#pragma unroll
                            for (int j = 0; j < 4; ++j) { v0[j] = gelu_tanh(v0[j]); v1[j] = gelu_tanh(v1[j]); } }
                        else if (type == 5) {
#pragma unroll
                            for (int j = 0; j < 4; ++j) { v0[j] = v0[j] * sigmoidf_fast(v0[j]); v1[j] = v1[j] * sigmoidf_fast(v1[j]); } }
                        u32x4 w; w.x = cvt_pk_bf16(v0[0], v0[1]); w.y = cvt_pk_bf16(v0[2], v0[3]); w.z = cvt_pk_bf16(v1[0], v1[1]); w.w = cvt_pk_bf16(v1[2], v1[3]);
                        *(u32x4*)(ob + (size_t)row * 512 + cs + bj * HALF) = w; } }
        }
    }
};
struct EpiSq {
    static constexpr bool PERM = true, AFTER_DRAIN = false;
    const float* rowss; bf16_t* O; int ldc;
    __device__ __forceinline__ void operator()(const f32x4 (&acc)[2][2][4][2], const Unit& u, int wr, int wc, int fr, int fq) const {
        const int row0 = u.pm * BM + wr * 64 + fr, col0 = u.pn * BM + wc * 32 + 8 * fq;
#pragma unroll
        for (int ai = 0; ai < 2; ++ai)
#pragma unroll
            for (int m = 0; m < 4; ++m) { const int row = row0 + ai * HALF + m * 16; const float r = rsqrtf(rowss[row] * (1.0f / 1024.0f) + 1e-6f);
#pragma unroll
                for (int bj = 0; bj < 2; ++bj) { f32x4 v0 = acc[ai][bj][m][0] * r, v1 = acc[ai][bj][m][1] * r;
#pragma unroll
                    for (int j = 0; j < 4; ++j) { const float a = fmaxf(v0[j], 0.f), b = fmaxf(v1[j], 0.f); v0[j] = a * a; v1[j] = b * b; }
                    u32x4 w; w.x = cvt_pk_bf16(v0[0], v0[1]); w.y = cvt_pk_bf16(v0[2], v0[3]); w.z = cvt_pk_bf16(v1[0], v1[1]); w.w = cvt_pk_bf16(v1[2], v1[3]);
                    *(u32x4*)(O + (size_t)row * ldc + col0 + bj * HALF) = w; } }
    }
};
struct EpiRes {
    static constexpr bool PERM = true, AFTER_DRAIN = false;
    const float* xin; float* xout; bf16_t* xb; float* ss_out;
    __device__ __forceinline__ void operator()(const f32x4 (&acc)[2][2][4][2], const Unit& u, int wr, int wc, int fr, int fq) const {
        const int row0 = u.pm * BM + wr * 64 + fr, col0 = u.pn * BM + wc * 32 + 8 * fq;
#pragma unroll
        for (int ai = 0; ai < 2; ++ai)
#pragma unroll
            for (int m = 0; m < 4; ++m) { const int row = row0 + ai * HALF + m * 16; float ss = 0.f;
#pragma unroll
                for (int bj = 0; bj < 2; ++bj) { const size_t off = (size_t)row * 1024 + col0 + bj * HALF;
                    const f32x4 a0 = *(const f32x4*)(xin + off), a1 = *(const f32x4*)(xin + off + 4);
                    const f32x4 o0 = a0 + acc[ai][bj][m][0], o1 = a1 + acc[ai][bj][m][1];
                    *(f32x4*)(xout + off) = o0; *(f32x4*)(xout + off + 4) = o1;
                    u32x4 w; w.x = cvt_pk_bf16(o0[0], o0[1]); w.y = cvt_pk_bf16(o0[2], o0[3]); w.z = cvt_pk_bf16(o1[0], o1[1]); w.w = cvt_pk_bf16(o1[2], o1[3]);
                    *(u32x4*)(xb + off) = w;
                    ss += (o0[0] * o0[0] + o0[1] * o0[1]) + (o0[2] * o0[2] + o0[3] * o0[3]) + (o1[0] * o1[0] + o1[1] * o1[1]) + (o1[2] * o1[2] + o1[3] * o1[3]); }
                ss += __shfl_xor(ss, 16); ss += __shfl_xor(ss, 32);
                if (fq == 0) atomicAdd(ss_out + row, ss); }
    }
};

template <class Epi, class Sched, bool ALIGN_EPI = false, bool SP2 = false>
__device__ __forceinline__ void gemm_phase(PG8_LAS unsigned char* lds, const Gemm g, const Sched& S, const Epi& E) {
    int tid_ = threadIdx.x; asm volatile("" : "+v"(tid_));
    const int tid = tid_, wid = __builtin_amdgcn_readfirstlane(tid >> 6), lane = tid & 63, wr = wid >> 2, wc = wid & 3, fr = lane & 15, fq = lane >> 4;
    const int K = g.K, nt = K / BK;
    unsigned voffA[2], voffB[2];
#pragma unroll
    for (int i = 0; i < 2; ++i) { int R, C; stage_rc(tid * 16 + i * 8192, R, C); const int Rb = Epi::PERM ? ((R & ~31) + perm32(R & 31)) : R;
        voffA[i] = (unsigned)(R * K + C) * 2u; voffB[i] = (unsigned)(Rb * K + C) * 2u; }
    const size_t kstep = (size_t)(BK * 2);
    const size_t hstep = (size_t)HALF * K * 2;
    const size_t tstep = 2 * hstep;
    const unsigned ldsw = (unsigned)wid * 1024u;
    const int aoff = lds_byte(wr * 64 + fr, fq * 8), boff = lds_byte(wc * 32 + fr, fq * 8);
#define PG8_SA(b, h) (((b) * 2 + (h)) * HTB)
#define PG8_SB(b, h) ((4 + (b) * 2 + (h)) * HTB)
#define PG8_STAGE(bufoff, gbase, voff) do { _Pragma("unroll") for (int _i = 0; _i < 2; ++_i) \
        __builtin_amdgcn_global_load_lds((const unsigned*)((const char*)(gbase) + (voff)[_i]), (PG8_LAS unsigned*)(lds + (bufoff) + ldsw + _i * 8192), 16, 0, 0); } while (0)
#define PG8_LDA(dst, b, h) do { _Pragma("unroll") for (int m = 0; m < 4; ++m) _Pragma("unroll") for (int k = 0; k < 2; ++k) dst[m][k] = *(const PG8_LAS bf16x8*)(lds + PG8_SA(b, h) + aoff + m * 2048 + k * 1024); } while (0)
#define PG8_LDB(dst, b, h) do { _Pragma("unroll") for (int n = 0; n < 2; ++n) _Pragma("unroll") for (int k = 0; k < 2; ++k) dst[n][k] = *(const PG8_LAS bf16x8*)(lds + PG8_SB(b, h) + boff + n * 2048 + k * 1024); } while (0)
#define PG8_MMA(ai, bj, At, Bt) do { __builtin_amdgcn_s_setprio(1); _Pragma("unroll") for (int m = 0; m < 4; ++m) _Pragma("unroll") for (int n = 0; n < 2; ++n) _Pragma("unroll") for (int k = 0; k < 2; ++k) \
        acc[ai][bj][m][n] = __builtin_amdgcn_mfma_f32_16x16x32_bf16(Bt[n][k], At[m][k], acc[ai][bj][m][n], 0, 0, 0); __builtin_amdgcn_s_setprio(0); } while (0)
#define PG8_WAIT_V(n) asm volatile("s_waitcnt vmcnt(" #n ")" ::: "memory")
#define PG8_WAIT_L(n) asm volatile("s_waitcnt lgkmcnt(" #n ")" ::: "memory")
#define PG8_BAR __builtin_amdgcn_s_barrier()
#define PG8_SCHED __builtin_amdgcn_sched_barrier(0)
    Unit cur, nxt; int ui = 0;
    if (!S.next(0, cur)) return;
    f32x4 acc[2][2][4][2];
#pragma unroll
    for (int a = 0; a < 2; ++a)
#pragma unroll
        for (int b = 0; b < 2; ++b)
#pragma unroll
            for (int m = 0; m < 4; ++m)
#pragma unroll
                for (int n = 0; n < 2; ++n) acc[a][b][m][n] = (f32x4){0.f, 0.f, 0.f, 0.f};
    bf16x8 At[4][2], B0[2][2], B1[2][2];
    const char* cA = (const char*)g.A + (size_t)cur.pm * tstep; const char* cB = (const char*)g.Bt + (size_t)cur.pn * tstep;
    S.a_ready(cur);
    if constexpr (SP2) {
        PG8_STAGE(PG8_SB(0, 0), cB, voffB); PG8_STAGE(PG8_SB(0, 1), cB + hstep, voffB); PG8_STAGE(PG8_SA(0, 0), cA, voffA); PG8_STAGE(PG8_SA(0, 1), cA + hstep, voffA);
        if (wr == 1) PG8_BAR;
        PG8_WAIT_V(2); PG8_BAR;
        PG8_STAGE(PG8_SB(1, 0), cB + kstep, voffB); PG8_STAGE(PG8_SA(1, 0), cA + kstep, voffA); PG8_STAGE(PG8_SB(1, 1), cB + hstep + kstep, voffB);
        PG8_WAIT_V(6); PG8_BAR;
    } else {
        PG8_STAGE(PG8_SB(0, 0), cB, voffB); PG8_STAGE(PG8_SA(0, 0), cA, voffA); PG8_STAGE(PG8_SB(0, 1), cB + hstep, voffB); PG8_STAGE(PG8_SA(0, 1), cA + hstep, voffA);
        if (wr == 1) PG8_BAR;
        PG8_WAIT_V(4); PG8_BAR;
        PG8_STAGE(PG8_SB(1, 0), cB + kstep, voffB); PG8_STAGE(PG8_SA(1, 0), cA + kstep, voffA); PG8_STAGE(PG8_SB(1, 1), cB + hstep + kstep, voffB);
        PG8_WAIT_V(6); PG8_BAR;
    }
    for (;;) {
        const bool has_next = S.next(ui + 1, nxt);
        const char* nA = has_next ? (const char*)g.A + (size_t)nxt.pm * tstep : cA; const char* nB = has_next ? (const char*)g.Bt + (size_t)nxt.pn * tstep : cB;
        for (int t = 0; t < nt; t += 2) {
            const bool last = (t == nt - 2);
            const char* a1 = cA + (size_t)(t + 1) * kstep;
            const char* a2 = last ? nA : cA + (size_t)(t + 2) * kstep; const char* b2 = last ? nB : cB + (size_t)(t + 2) * kstep;
            const char* a3 = a2 + kstep; const char* b3 = b2 + kstep;
            if (last && has_next) S.a_ready(nxt);
            if constexpr (SP2) {
            PG8_LDB(B0, 0, 0); PG8_LDB(B1, 0, 1); PG8_SCHED; PG8_LDA(At, 0, 0); PG8_STAGE(PG8_SA(1, 1), a1 + hstep, voffA);
            PG8_WAIT_V(8); PG8_WAIT_L(0); PG8_BAR; PG8_MMA(0, 0, At, B0); PG8_MMA(0, 1, At, B1); PG8_BAR; PG8_SCHED;
            PG8_LDA(At, 0, 1); PG8_STAGE(PG8_SB(0, 0), b2, voffB); PG8_STAGE(PG8_SB(0, 1), b2 + hstep, voffB); PG8_STAGE(PG8_SA(0, 0), a2, voffA);
            PG8_WAIT_V(8); PG8_WAIT_L(0); PG8_BAR; PG8_MMA(1, 0, At, B0); PG8_MMA(1, 1, At, B1); PG8_BAR; PG8_SCHED;
            PG8_LDB(B0, 1, 0); PG8_LDB(B1, 1, 1); PG8_SCHED; PG8_LDA(At, 1, 0); PG8_STAGE(PG8_SA(0, 1), a2 + hstep, voffA);
            PG8_WAIT_V(8); PG8_WAIT_L(0); PG8_BAR; PG8_MMA(0, 0, At, B0); PG8_MMA(0, 1, At, B1); PG8_BAR; PG8_SCHED;
            PG8_LDA(At, 1, 1); PG8_STAGE(PG8_SB(1, 0), b3, voffB); PG8_STAGE(PG8_SB(1, 1), b3 + hstep, voffB); PG8_STAGE(PG8_SA(1, 0), a3, voffA);
            PG8_WAIT_V(8); PG8_WAIT_L(0); PG8_BAR; PG8_MMA(1, 0, At, B0); PG8_MMA(1, 1, At, B1); PG8_BAR; PG8_SCHED;
            } else {
            PG8_LDB(B0, 0, 0); PG8_SCHED; PG8_LDA(At, 0, 0); PG8_STAGE(PG8_SA(1, 1), a1 + hstep, voffA);
            PG8_WAIT_L(8); PG8_BAR; PG8_WAIT_L(0); PG8_MMA(0, 0, At, B0); PG8_BAR; PG8_SCHED;
            PG8_LDB(B1, 0, 1); PG8_STAGE(PG8_SB(0, 0), b2, voffB);
            PG8_BAR; PG8_WAIT_L(0); PG8_MMA(0, 1, At, B1); PG8_BAR;
            PG8_LDA(At, 0, 1); PG8_STAGE(PG8_SA(0, 0), a2, voffA);
            PG8_BAR; PG8_WAIT_L(0); PG8_MMA(1, 0, At, B0); PG8_BAR; PG8_SCHED;
            PG8_STAGE(PG8_SB(0, 1), b2 + hstep, voffB);
            PG8_WAIT_V(6); PG8_BAR; PG8_MMA(1, 1, At, B1); PG8_BAR;
            PG8_LDB(B0, 1, 0); PG8_SCHED; PG8_LDA(At, 1, 0); PG8_STAGE(PG8_SA(0, 1), a2 + hstep, voffA);
            PG8_WAIT_L(8); PG8_BAR; PG8_WAIT_L(0); PG8_MMA(0, 0, At, B0); PG8_BAR; PG8_SCHED;
            PG8_LDB(B1, 1, 1); PG8_STAGE(PG8_SB(1, 0), b3, voffB);
            PG8_BAR; PG8_WAIT_L(0); PG8_MMA(0, 1, At, B1); PG8_BAR;
            PG8_LDA(At, 1, 1); PG8_STAGE(PG8_SA(1, 0), a3, voffA);
            PG8_BAR; PG8_WAIT_L(0); PG8_MMA(1, 0, At, B0); PG8_BAR; PG8_SCHED;
            PG8_STAGE(PG8_SB(1, 1), b3 + hstep, voffB);
            PG8_WAIT_V(6); PG8_BAR; PG8_MMA(1, 1, At, B1); PG8_BAR;
            }
        }
        if constexpr (ALIGN_EPI) { if (wr == 0) PG8_BAR; }
        if constexpr (!Epi::AFTER_DRAIN) { E(acc, cur, wr, wc, fr, fq); S.done(cur); }
        if (!has_next) break;
#pragma unroll
        for (int a = 0; a < 2; ++a)
#pragma unroll
            for (int b = 0; b < 2; ++b)
#pragma unroll
                for (int m = 0; m < 4; ++m)
#pragma unroll
                    for (int n = 0; n < 2; ++n) acc[a][b][m][n] = (f32x4){0.f, 0.f, 0.f, 0.f};
        cur = nxt; cA = nA; cB = nB; ++ui;
        if constexpr (ALIGN_EPI) { if (wr == 1) PG8_BAR; }
    }
    PG8_WAIT_V(0);
    if constexpr (!ALIGN_EPI) { if (wr == 0) PG8_BAR; }
    PG8_BAR;
    if constexpr (Epi::AFTER_DRAIN) { E.fused(acc, cur, wr, wc, fr, fq, lds, wid, lane); S.done(cur); }
#undef PG8_SA
#undef PG8_SB
#undef PG8_STAGE
#undef PG8_LDA
#undef PG8_LDB
#undef PG8_MMA
#undef PG8_WAIT_V
#undef PG8_WAIT_L
#undef PG8_BAR
#undef PG8_SCHED
}
}

#ifndef MK_N_LAUNCHES
#define MK_N_LAUNCHES 1
#endif
constexpr int NWAVES = 8, NTHR = 512;
constexpr int M = 16384, D = 1024, DIN = 3072, DFF = 4096, SEQ = 4096;
constexpr int NPHASE = 14;
constexpr float EPS = 1e-6f;
constexpr size_t MiB = 1u << 20;
constexpr size_t WS_SS = 0, SS_BYTES = 5 * (size_t)M * 4;
constexpr size_t WS_LB = 512 * 1024;
constexpr size_t WS_W = 1 * MiB, W_LAYER = 24 * MiB, W_IN = 0, W_OUT = 6 * MiB, W_UP = 8 * MiB, W_DOWN = 16 * MiB;
constexpr size_t WS_XB = 49 * MiB;
constexpr size_t WS_H = 81 * MiB;
constexpr size_t WS_U = 81 * MiB, WS_V = 97 * MiB, WS_Q = 113 * MiB, WS_LF = 129 * MiB, WS_I = 161 * MiB, WS_G = 177 * MiB, WS_Y = 193 * MiB, WS_SLOC = 225 * MiB, WS_DTOT = 241 * MiB;
constexpr size_t WS_END = 242 * MiB;
constexpr int LDS_BYTES = 147456;

#define LAS __attribute__((address_space(3)))
typedef unsigned short bf16;
typedef unsigned v4u __attribute__((ext_vector_type(4)));
typedef unsigned v2u __attribute__((ext_vector_type(2)));
typedef float f32x4 __attribute__((ext_vector_type(4)));
typedef float f32x16 __attribute__((ext_vector_type(16)));
typedef short bf16x8 __attribute__((ext_vector_type(8)));
#define LDS_WAIT() asm volatile("s_waitcnt lgkmcnt(0)" ::: "memory")
__device__ __forceinline__ unsigned pkbf(float lo, float hi) { return pg8::cvt_pk_bf16(lo, hi); }
__device__ __forceinline__ float bf_lo(unsigned w) { return __uint_as_float(w << 16); }
__device__ __forceinline__ float bf_hi(unsigned w) { return __uint_as_float(w & 0xffff0000u); }
__device__ __forceinline__ float bf1(bf16 v) { return __uint_as_float(((unsigned)v) << 16); }
__device__ __forceinline__ bf16 tobf(float f) { return (bf16)(pg8::cvt_pk_bf16(f, 0.f) & 0xffffu); }
__device__ __forceinline__ float wave_sum(float v) {
#pragma unroll
    for (int o = 1; o < 64; o <<= 1) v += __shfl_xor(v, o);
    return v;
}

__device__ __forceinline__ void p0_transpose_item(const float* W, int K, int N, bf16* WT, const float* ksc, LAS float* scr, int item, int lane) {
    const int nblk = N / 32, kb = item / nblk, nb = item % nblk, k0 = 64 * kb, n0 = 32 * nb;
#pragma unroll 8
    for (int i = 0; i < 32; ++i) { const int kk = 2 * i + (lane >> 5); const float s = ksc ? ksc[k0 + kk] : 1.0f; scr[kk * 33 + (lane & 31)] = W[(size_t)(k0 + kk) * N + n0 + (lane & 31)] * s; }
    LDS_WAIT(); asm volatile("" ::: "memory");
    const int c = lane & 7;
#pragma unroll
    for (int j = 0; j < 4; ++j) { const int n = (lane >> 3) + 8 * j; const LAS float* s = scr + (8 * c) * 33 + n;
        v4u o; o.x = pkbf(s[0 * 33], s[1 * 33]); o.y = pkbf(s[2 * 33], s[3 * 33]); o.z = pkbf(s[4 * 33], s[5 * 33]); o.w = pkbf(s[6 * 33], s[7 * 33]);
        *(v4u*)(WT + (size_t)(n0 + n) * K + k0 + 8 * c) = o; }
    LDS_WAIT(); asm volatile("" ::: "memory");
}

struct Args { const float* in[14]; float* out; unsigned char* ws; int ph_lo, ph_hi; };

__device__ __forceinline__ void p0_prologue(const Args& a, LAS unsigned char* lds, int tid_) {
    int tid = tid_; asm volatile("" : "+v"(tid));
    const int lane = tid & 63, wave = tid >> 6;
    LAS float* scr = (LAS float*)(lds + wave * 16384);
    const int gw = blockIdx.x * NWAVES + wave, NGW = gridDim.x * NWAVES;
    constexpr int I_IN = (D / 64) * (DIN / 32), I_OUT = (D / 64) * (D / 32), I_UP = (D / 64) * (DFF / 32), I_DN = (DFF / 64) * (D / 32), I_L = I_IN + I_OUT + I_UP + I_DN;
    for (int it = gw; it < 2 * I_L; it += NGW) {
        const int l = it / I_L; int r = it % I_L;
        unsigned char* wl = a.ws + WS_W + (size_t)l * W_LAYER;
        if (r < I_IN) { p0_transpose_item(a.in[2] + (size_t)l * D * DIN, D, DIN, (bf16*)(wl + W_IN), a.in[1] + l * D, scr, r, lane); continue; } r -= I_IN;
        if (r < I_OUT) { p0_transpose_item(a.in[9] + (size_t)l * D * D, D, D, (bf16*)(wl + W_OUT), nullptr, scr, r, lane); continue; } r -= I_OUT;
        if (r < I_UP) { p0_transpose_item(a.in[11] + (size_t)l * D * DFF, D, DFF, (bf16*)(wl + W_UP), a.in[10] + l * D, scr, r, lane); continue; } r -= I_UP;
        p0_transpose_item(a.in[12] + (size_t)l * DFF * D, DFF, D, (bf16*)(wl + W_DOWN), nullptr, scr, r, lane);
    }
    bf16* XB = (bf16*)(a.ws + WS_XB); float* ss0 = (float*)(a.ws + WS_SS);
    for (int m = gw; m < M; m += NGW) {
        const f32x4* xr = (const f32x4*)(a.in[0] + (size_t)m * D) + lane; float s = 0.f;
        unsigned long long* o8 = (unsigned long long*)(XB + (size_t)m * D) + lane;
#pragma unroll
        for (int j = 0; j < 4; ++j) { const f32x4 v = xr[64 * j]; s += (v.x * v.x + v.y * v.y) + (v.z * v.z + v.w * v.w);
            o8[64 * j] = (unsigned long long)pkbf(v.x, v.y) | ((unsigned long long)pkbf(v.z, v.w) << 32); }
        s = wave_sum(s);
        if (lane == 0) ss0[m] = s;
    }
    if (blockIdx.x == 0) { float* lbv = (float*)(a.ws + WS_LB); const float* lw = a.in[7];
        for (int c = tid; c < 512; c += NTHR) { const float a0 = lw[c], a1 = lw[512 + c]; lbv[c] = 0.f; lbv[512 + c] = 1.0f / (1.0f + expf(a0 - a1)); } }
}

__device__ __forceinline__ void gmlp_item(LAS unsigned char* lds, int item, const bf16* U, const bf16* V, const float* Wsp, const float* bsp, const float* gv, const float* go, bf16* Y, int tid_) {
    int tid = tid_; asm volatile("" : "+v"(tid));
    const int g = item & 3, row0 = (item >> 2) * 128;
    const int lane = tid & 63, w = tid >> 6, r = lane & 31, hh = lane >> 5;
    LAS unsigned char* VnT = lds; LAS float* red = (LAS float*)(lds + 34816); LAS float* ssqb = (LAS float*)(lds + 38912);
    __syncthreads();
    {
        const int sp = lane, cr = w;
        const bf16* vp = V + (size_t)(row0 + 2 * sp) * 512 + g * 128 + cr * 16;
        const v4u a0 = *(const v4u*)vp, a1 = *(const v4u*)(vp + 8), b0 = *(const v4u*)(vp + 512), b1 = *(const v4u*)(vp + 520);
        float va[16], vb[16];
#pragma unroll
        for (int j = 0; j < 4; ++j) { va[2 * j] = bf_lo(a0[j]); va[2 * j + 1] = bf_hi(a0[j]); va[8 + 2 * j] = bf_lo(a1[j]); va[9 + 2 * j] = bf_hi(a1[j]);
            vb[2 * j] = bf_lo(b0[j]); vb[2 * j + 1] = bf_hi(b0[j]); vb[8 + 2 * j] = bf_lo(b1[j]); vb[9 + 2 * j] = bf_hi(b1[j]); }
        float sa = 0.f, sb = 0.f;
#pragma unroll
        for (int j = 0; j < 16; ++j) { sa += va[j] * va[j]; sb += vb[j] * vb[j]; }
        red[cr * 128 + 2 * sp] = sa; red[cr * 128 + 2 * sp + 1] = sb;
        __syncthreads();
        float ta = 0.f, tb = 0.f;
#pragma unroll
        for (int k = 0; k < 8; ++k) { ta += red[k * 128 + 2 * sp]; tb += red[k * 128 + 2 * sp + 1]; }
        const float ra = rsqrtf(ta * (1.0f / 128.0f) + EPS), rb = rsqrtf(tb * (1.0f / 128.0f) + EPS);
#pragma unroll
        for (int j = 0; j < 16; ++j) { const int c = cr * 16 + j; const float gw = gv[g * 128 + c];
            *(LAS unsigned*)(VnT + c * 272 + sp * 4) = pkbf(va[j] * ra * gw, vb[j] * rb * gw); }
    }
    __syncthreads();
    const int cb = w >> 1;
    f32x16 acc[2]; float yv[2][16];
#pragma unroll
    for (int x = 0; x < 2; ++x) {
        const int tb = (w & 1) ? (x == 0 ? 1 : 2) : (x == 0 ? 0 : 3);
        const int t = tb * 32 + r;
#pragma unroll
        for (int q = 0; q < 16; ++q) acc[x][q] = 0.f;
        const float* wrow = Wsp + (size_t)(g * 128 + t) * 128 + 8 * hh;
        const int nks = (tb + 1) * 2;
        for (int ks = 0; ks < nks; ++ks) {
            const bf16x8 af = *(const LAS bf16x8*)(VnT + (cb * 32 + r) * 272 + (ks * 16 + 8 * hh) * 2);
            const f32x4 w0 = *(const f32x4*)(wrow + ks * 16), w1 = *(const f32x4*)(wrow + ks * 16 + 4);
            const int s0 = ks * 16 + 8 * hh;
            float e[8] = {w0[0], w0[1], w0[2], w0[3], w1[0], w1[1], w1[2], w1[3]};
#pragma unroll
            for (int j = 0; j < 8; ++j) e[j] = (s0 + j <= t) ? e[j] : 0.f;
            v4u bw; bw.x = pkbf(e[0], e[1]); bw.y = pkbf(e[2], e[3]); bw.z = pkbf(e[4], e[5]); bw.w = pkbf(e[6], e[7]);
            acc[x] = __builtin_amdgcn_mfma_f32_32x32x16_bf16(af, __builtin_bit_cast(bf16x8, bw), acc[x], 0, 0, 0);
        }
        const float bias = bsp[g * 128 + t]; float ssq = 0.f;
#pragma unroll
        for (int i = 0; i < 4; ++i) { const int c = cb * 32 + 8 * i + 4 * hh;
            const v2u uw = *(const v2u*)(U + (size_t)(row0 + t) * 512 + g * 128 + c);
            const float u0 = bf_lo(uw.x), u1 = bf_hi(uw.x), u2 = bf_lo(uw.y), u3 = bf_hi(uw.y);
            yv[x][4 * i + 0] = u0 * (acc[x][4 * i + 0] + bias); yv[x][4 * i + 1] = u1 * (acc[x][4 * i + 1] + bias);
            yv[x][4 * i + 2] = u2 * (acc[x][4 * i + 2] + bias); yv[x][4 * i + 3] = u3 * (acc[x][4 * i + 3] + bias);
#pragma unroll
            for (int j = 0; j < 4; ++j) ssq += yv[x][4 * i + j] * yv[x][4 * i + j]; }
        ssq += __shfl_xor(ssq, 32);
        if (hh == 0) ssqb[cb * 128 + t] = ssq;
    }
    __syncthreads();
#pragma unroll
    for (int x = 0; x < 2; ++x) {
        const int tb = (w & 1) ? (x == 0 ? 1 : 2) : (x == 0 ? 0 : 3);
        const int t = tb * 32 + r;
        const float tot = (ssqb[t] + ssqb[128 + t]) + (ssqb[256 + t] + ssqb[384 + t]);
        const float rs = rsqrtf(tot * (1.0f / 128.0f) + EPS);
#pragma unroll
        for (int i = 0; i < 4; ++i) { const int c = cb * 32 + 8 * i + 4 * hh; const f32x4 gw = *(const f32x4*)(go + g * 128 + c);
            v2u o; o.x = pkbf(yv[x][4 * i] * rs * gw[0], yv[x][4 * i + 1] * rs * gw[1]); o.y = pkbf(yv[x][4 * i + 2] * rs * gw[2], yv[x][4 * i + 3] * rs * gw[3]);
            *(v2u*)(Y + (size_t)(row0 + t) * 1024 + g * 128 + c) = o; }
    }
}

template <bool OUT>
__device__ __forceinline__ void hgrn_item(LAS unsigned char* lds, int item, const bf16* Q, const float* LF, const bf16* I, const bf16* G, const float* gbo, float* SLOC, float* DTOT, bf16* Y, int tid_) {
    int tid = tid_; asm volatile("" : "+v"(tid));
    const int sc = item & 15, bh = item >> 4, b = bh >> 2, h = bh & 3;
    const int rowbase = b * SEQ + sc * 256;
    const int lane = tid & 63, w = tid >> 6, r = lane & 31, hh = lane >> 5;
    LAS unsigned char* Q1s = lds; LAS unsigned char* K1s = lds + 17408; LAS unsigned char* K2T = lds + 34816; LAS unsigned char* VT = lds + 53248;
    LAS unsigned char* ST = lds + 71680; LAS unsigned char* Ps = lds + 106496;
    LAS float* totb = (LAS float*)(lds + 115712); LAS float* dl = (LAS float*)(lds + 117760); LAS float* ssqb = (LAS float*)(lds + 118272);
    const int kb = w >> 1, vb0 = (w & 1) * 2;
    const int vb = w >> 1, tb = w & 1;
    f32x16 S[2];
#pragma unroll
    for (int x = 0; x < 2; ++x)
#pragma unroll
        for (int q = 0; q < 16; ++q) S[x][q] = 0.f;
    __syncthreads();
    if (OUT) {
        for (int m = 0; m < sc; ++m) {
            const float* dt = DTOT + (size_t)(bh * 16 + m) * 128; const float* sl = SLOC + (size_t)(bh * 16 + m) * 16384;
#pragma unroll
            for (int i = 0; i < 4; ++i) { const int k0 = kb * 32 + 8 * i + 4 * hh; const f32x4 d4 = *(const f32x4*)(dt + k0);
#pragma unroll
                for (int x = 0; x < 2; ++x)
#pragma unroll
                    for (int j = 0; j < 4; ++j) S[x][4 * i + j] = d4[j] * S[x][4 * i + j] + sl[(size_t)(k0 + j) * 128 + (vb0 + x) * 32 + r]; }
        }
#pragma unroll
        for (int x = 0; x < 2; ++x)
#pragma unroll
            for (int i = 0; i < 4; ++i) { v2u o; o.x = pkbf(S[x][4 * i], S[x][4 * i + 1]); o.y = pkbf(S[x][4 * i + 2], S[x][4 * i + 3]);
                *(LAS v2u*)(ST + ((vb0 + x) * 32 + r) * 272 + (kb * 32 + 8 * i + 4 * hh) * 2) = o; }
    }
    const int ch = tid & 127, part = tid >> 7;
    float btot = 0.f;
    for (int jc = 0; jc < 4; ++jc) {
        const int row0 = rowbase + jc * 64;
        float cs[16]; unsigned short iv[16], qv[16];
        {
            const size_t e0 = (size_t)(row0 + part * 16) * 512 + h * 128 + ch;
#pragma unroll
            for (int i = 0; i < 16; ++i) { cs[i] = LF[e0 + (size_t)i * 512]; iv[i] = I[e0 + (size_t)i * 512]; if (OUT) qv[i] = Q[e0 + (size_t)i * 512]; }
        }
        float lfv[16];
#pragma unroll
        for (int i = 0; i < 16; ++i) lfv[i] = cs[i];
#pragma unroll
        for (int i = 1; i < 16; ++i) cs[i] += cs[i - 1];
        totb[part * 128 + ch] = cs[15];
        __syncthreads();
        const float t0 = totb[ch], t1 = totb[128 + ch], t2 = totb[256 + ch], t3 = totb[384 + ch];
        const float off = (part > 0 ? t0 : 0.f) + (part > 1 ? t1 : 0.f) + (part > 2 ? t2 : 0.f);
        const float bl = (t0 + t1) + (t2 + t3);
        {
            unsigned k2w[8], vw[8];
#pragma unroll
            for (int i = 0; i < 16; i += 2) {
                const float b0 = off + cs[i], b1 = off + cs[i + 1];
                const float k0 = 1.0f - __expf(lfv[i]), k1 = 1.0f - __expf(lfv[i + 1]);
                k2w[i >> 1] = pkbf(k0 * __expf(bl - b0), k1 * __expf(bl - b1));
                vw[i >> 1] = (unsigned)iv[i] | ((unsigned)iv[i + 1] << 16);
                if (OUT) {
                    const float q0 = bf1(qv[i]) * __expf(b0), q1 = bf1(qv[i + 1]) * __expf(b1);
                    const float c0 = k0 * __expf(fminf(-b0, 80.f)), c1 = k1 * __expf(fminf(-b1, 80.f));
                    *(LAS bf16*)(Q1s + (part * 16 + i) * 272 + ch * 2) = tobf(q0); *(LAS bf16*)(Q1s + (part * 16 + i + 1) * 272 + ch * 2) = tobf(q1);
                    *(LAS bf16*)(K1s + (part * 16 + i) * 272 + ch * 2) = tobf(c0); *(LAS bf16*)(K1s + (part * 16 + i + 1) * 272 + ch * 2) = tobf(c1);
                }
            }
            *(LAS v4u*)(K2T + ch * 144 + part * 32) = (v4u){k2w[0], k2w[1], k2w[2], k2w[3]}; *(LAS v4u*)(K2T + ch * 144 + part * 32 + 16) = (v4u){k2w[4], k2w[5], k2w[6], k2w[7]};
            *(LAS v4u*)(VT + ch * 144 + part * 32) = (v4u){vw[0], vw[1], vw[2], vw[3]}; *(LAS v4u*)(VT + ch * 144 + part * 32 + 16) = (v4u){vw[4], vw[5], vw[6], vw[7]};
            if (part == 0) { dl[ch] = __expf(bl); btot += bl; }
        }
        __syncthreads();
        f32x16 accO;
#pragma unroll
        for (int q = 0; q < 16; ++q) accO[q] = 0.f;
        if (OUT) {
            if (w < 3) {
                const int sb = (w == 2) ? 1 : 0, tbs = (w == 0) ? 0 : 1;
                f32x16 sa;
#pragma unroll
                for (int q = 0; q < 16; ++q) sa[q] = 0.f;
#pragma unroll
                for (int ks = 0; ks < 8; ++ks) {
                    const bf16x8 af = *(const LAS bf16x8*)(K1s + (sb * 32 + r) * 272 + (ks * 16 + 8 * hh) * 2);
                    const bf16x8 bfr = *(const LAS bf16x8*)(Q1s + (tbs * 32 + r) * 272 + (ks * 16 + 8 * hh) * 2);
                    sa = __builtin_amdgcn_mfma_f32_32x32x16_bf16(af, bfr, sa, 0, 0, 0);
                }
                const int t = tbs * 32 + r;
#pragma unroll
                for (int i = 0; i < 4; ++i) { const int s0 = sb * 32 + 8 * i + 4 * hh;
                    const float p0 = (s0 + 0 <= t) ? sa[4 * i + 0] : 0.f, p1 = (s0 + 1 <= t) ? sa[4 * i + 1] : 0.f, p2 = (s0 + 2 <= t) ? sa[4 * i + 2] : 0.f, p3 = (s0 + 3 <= t) ? sa[4 * i + 3] : 0.f;
                    v2u o; o.x = pkbf(p0, p1); o.y = pkbf(p2, p3);
                    *(LAS v2u*)(Ps + t * 144 + s0 * 2) = o; }
            }
#pragma unroll
            for (int ks = 0; ks < 8; ++ks) {
                const bf16x8 af = *(const LAS bf16x8*)(ST + (vb * 32 + r) * 272 + (ks * 16 + 8 * hh) * 2);
                const bf16x8 bfr = *(const LAS bf16x8*)(Q1s + (tb * 32 + r) * 272 + (ks * 16 + 8 * hh) * 2);
                accO = __builtin_amdgcn_mfma_f32_32x32x16_bf16(af, bfr, accO, 0, 0, 0);
            }
            __syncthreads();
            const int nks = (tb + 1) * 2;
            for (int ks = 0; ks < nks; ++ks) {
                const bf16x8 af = *(const LAS bf16x8*)(VT + (vb * 32 + r) * 144 + (ks * 16 + 8 * hh) * 2);
                const bf16x8 bfr = *(const LAS bf16x8*)(Ps + (tb * 32 + r) * 144 + (ks * 16 + 8 * hh) * 2);
                accO = __builtin_amdgcn_mfma_f32_32x32x16_bf16(af, bfr, accO, 0, 0, 0);
            }
        }
        if (!OUT || jc < 3) {
#pragma unroll
            for (int i = 0; i < 4; ++i) { const f32x4 d4 = *(const LAS f32x4*)(dl + kb * 32 + 8 * i + 4 * hh);
#pragma unroll
                for (int x = 0; x < 2; ++x)
#pragma unroll
                    for (int j = 0; j < 4; ++j) S[x][4 * i + j] *= d4[j]; }
#pragma unroll
            for (int ks = 0; ks < 4; ++ks) {
                const bf16x8 af = *(const LAS bf16x8*)(K2T + (kb * 32 + r) * 144 + (ks * 16 + 8 * hh) * 2);
#pragma unroll
                for (int x = 0; x < 2; ++x) {
                    const bf16x8 bfr = *(const LAS bf16x8*)(VT + ((vb0 + x) * 32 + r) * 144 + (ks * 16 + 8 * hh) * 2);
                    S[x] = __builtin_amdgcn_mfma_f32_32x32x16_bf16(af, bfr, S[x], 0, 0, 0);
                }
            }
            if (OUT) {
#pragma unroll
                for (int x = 0; x < 2; ++x)
#pragma unroll
                    for (int i = 0; i < 4; ++i) { v2u o; o.x = pkbf(S[x][4 * i], S[x][4 * i + 1]); o.y = pkbf(S[x][4 * i + 2], S[x][4 * i + 3]);
                        *(LAS v2u*)(ST + ((vb0 + x) * 32 + r) * 272 + (kb * 32 + 8 * i + 4 * hh) * 2) = o; }
            }
        }
        if (OUT) {
            float ssq = 0.f;
#pragma unroll
            for (int q = 0; q < 16; ++q) ssq += accO[q] * accO[q];
            ssq += __shfl_xor(ssq, 32);
            if (hh == 0) ssqb[vb * 64 + tb * 32 + r] = ssq;
        }
        __syncthreads();
        if (OUT) {
            const int tl = tb * 32 + r;
            const float tot = (ssqb[tl] + ssqb[64 + tl]) + (ssqb[128 + tl] + ssqb[192 + tl]);
            const float rs = rsqrtf(tot * (1.0f / 128.0f) + EPS);
#pragma unroll
            for (int i = 0; i < 4; ++i) { const int v0 = vb * 32 + 8 * i + 4 * hh;
                const v2u gw = *(const v2u*)(G + (size_t)(row0 + tl) * 512 + h * 128 + v0); const f32x4 nw = *(const f32x4*)(gbo + h * 128 + v0);
                v2u o; o.x = pkbf(accO[4 * i] * rs * nw[0] * bf_lo(gw.x), accO[4 * i + 1] * rs * nw[1] * bf_hi(gw.x));
                o.y = pkbf(accO[4 * i + 2] * rs * nw[2] * bf_lo(gw.y), accO[4 * i + 3] * rs * nw[3] * bf_hi(gw.y));
                *(v2u*)(Y + (size_t)(row0 + tl) * 1024 + 512 + h * 128 + v0) = o; }
        }
    }
    if (!OUT) {
        float* sl = SLOC + (size_t)(bh * 16 + sc) * 16384;
#pragma unroll
        for (int x = 0; x < 2; ++x)
#pragma unroll
            for (int q = 0; q < 16; ++q) { const int k = kb * 32 + (q & 3) + 8 * (q >> 2) + 4 * hh; sl[(size_t)k * 128 + (vb0 + x) * 32 + r] = S[x][q]; }
        if (part == 0) DTOT[(size_t)(bh * 16 + sc) * 128 + ch] = __expf(btot);
    }
}

__global__ void __launch_bounds__(NTHR, 2) fwd_megakernel(Args a) {
    extern __shared__ __attribute__((aligned(16))) unsigned char lds_raw[];
    LAS unsigned char* lds = (LAS unsigned char*)lds_raw;
    cg::grid_group grid = cg::this_grid();
    const int tid = threadIdx.x, G_ = gridDim.x;
    const int lo = a.ph_lo, hi = a.ph_hi;
    unsigned char* ws = a.ws;
#define IN(k) (lo <= (k) && (k) < hi)
#define SEAM(k) do { if (IN(k) && IN((k) + 1)) grid.sync(); } while (0)
    float* rowss = (float*)(ws + WS_SS);
    bf16* XB = (bf16*)(ws + WS_XB); bf16* HB = (bf16*)(ws + WS_H);
    bf16* Ub = (bf16*)(ws + WS_U); bf16* Vb = (bf16*)(ws + WS_V); bf16* Qb = (bf16*)(ws + WS_Q); float* LFb = (float*)(ws + WS_LF); bf16* Ib = (bf16*)(ws + WS_I); bf16* Gb = (bf16*)(ws + WS_G);
    bf16* Yb = (bf16*)(ws + WS_Y); float* SLOC = (float*)(ws + WS_SLOC); float* DTOT = (float*)(ws + WS_DTOT);

#ifndef SKIP_P0
    if (IN(0)) { p0_prologue(a, lds, tid); __syncthreads(); }
#endif
    SEAM(0);
    for (int l = 0; l < 2; ++l) {
        const int p = 1 + 6 * l;
        unsigned char* wl = ws + WS_W + (size_t)l * W_LAYER;
#ifndef SKIP_G1
        if (IN(p)) {
            pg8::Gemm g{XB, (const bf16*)(wl + W_IN), M, DIN, D}; pg8::StaticOrder S; S.init(M, DIN, G_, (int)blockIdx.x);
            pg8::EpiIn E{rowss + (size_t)(2 * l) * M, (const float*)(ws + WS_LB) + l * 512, Ub, Vb, Qb, LFb, Ib, Gb};
            pg8::gemm_phase<pg8::EpiIn, pg8::StaticOrder, true, true>(lds, g, S, E);
        }
#endif
        SEAM(p);
#ifndef SKIP_MIX1
        if (IN(p + 1)) {
            for (int it = blockIdx.x; it < 256; it += G_)
                hgrn_item<false>(lds, it, Qb, LFb, Ib, Gb, a.in[8] + l * 512, SLOC, DTOT, Yb, tid);
            for (int it = blockIdx.x; it < 512; it += G_)
                gmlp_item(lds, it, Ub, Vb, a.in[3] + (size_t)l * 4 * 128 * 128, a.in[4] + l * 512, a.in[5] + l * 512, a.in[6] + l * 512, Yb, tid);
            __syncthreads();
        }
#endif
        SEAM(p + 1);
#ifndef SKIP_MIX2
        if (IN(p + 2)) {
            for (int it = blockIdx.x; it < 256; it += G_)
                hgrn_item<true>(lds, it, Qb, LFb, Ib, Gb, a.in[8] + l * 512, SLOC, DTOT, Yb, tid);
            __syncthreads();
        }
#endif
        SEAM(p + 2);
#ifndef SKIP_G2
        if (IN(p + 3)) {
            pg8::Gemm g{Yb, (const bf16*)(wl + W_OUT), M, D, D}; pg8::StaticOrder S; S.init(M, D, G_, (int)blockIdx.x);
            pg8::EpiRes E{l == 0 ? a.in[0] : a.out, a.out, XB, rowss + (size_t)(2 * l + 1) * M};
            pg8::gemm_phase<pg8::EpiRes, pg8::StaticOrder, false, true>(lds, g, S, E);
        }
#endif
        SEAM(p + 3);
#ifndef SKIP_G3
        if (IN(p + 4)) {
            pg8::Gemm g{XB, (const bf16*)(wl + W_UP), M, DFF, D}; pg8::StaticOrder S; S.init(M, DFF, G_, (int)blockIdx.x);
            pg8::EpiSq E{rowss + (size_t)(2 * l + 1) * M, HB, DFF};
            pg8::gemm_phase<pg8::EpiSq, pg8::StaticOrder, true, true>(lds, g, S, E);
        }
#endif
        SEAM(p + 4);
#ifndef SKIP_G4
        if (IN(p + 5)) {
            pg8::Gemm g{HB, (const bf16*)(wl + W_DOWN), M, D, DFF}; pg8::StaticOrder S; S.init(M, D, G_, (int)blockIdx.x);
            pg8::EpiRes E{a.out, a.out, XB, rowss + (size_t)(2 * l + 2) * M};
            pg8::gemm_phase<pg8::EpiRes, pg8::StaticOrder, false, true>(lds, g, S, E);
        }
#endif
        SEAM(p + 5);
    }
    if (IN(13)) {
        const int lane = tid & 63, wave = tid >> 6; const float* ssf = rowss + (size_t)4 * M; const f32x4* nf = (const f32x4*)a.in[13] + lane;
        for (int m = blockIdx.x * NWAVES + wave; m < M; m += G_ * NWAVES) {
            const float rs = rsqrtf(ssf[m] * (1.0f / 1024.0f) + EPS);
            f32x4* xr = (f32x4*)(a.out + (size_t)m * D) + lane;
#pragma unroll
            for (int j = 0; j < 4; ++j) { const f32x4 v = xr[64 * j]; xr[64 * j] = v * rs * nf[64 * j]; }
        }
    }
#undef IN
#undef SEAM
}

extern "C" void kernel_launch(void* const* d_in, const int* in_sizes, int n_in, void* d_out, int out_size, void* d_ws, size_t ws_size, hipStream_t stream) {
    static int grid = 0;
    if (grid == 0) {
        if (n_in != 14 || in_sizes[0] != M * D || out_size != M * D || ws_size < WS_END) { fprintf(stderr, "kernel_launch: unexpected shapes (n_in %d, in0 %d, out %d, ws %zu)\n", n_in, n_in > 0 ? in_sizes[0] : -1, out_size, ws_size); grid = -1; return; }
        int dev = 0, cus = 0, per_cu = 0;
        if (hipGetDevice(&dev) != hipSuccess || hipDeviceGetAttribute(&cus, hipDeviceAttributeMultiprocessorCount, dev) != hipSuccess) { grid = -1; return; }
        if (hipFuncSetAttribute((const void*)fwd_megakernel, hipFuncAttributeMaxDynamicSharedMemorySize, LDS_BYTES) != hipSuccess) { fprintf(stderr, "kernel_launch: hipFuncSetAttribute failed\n"); grid = -1; return; }
        if (hipOccupancyMaxActiveBlocksPerMultiprocessor(&per_cu, (const void*)fwd_megakernel, NTHR, LDS_BYTES) != hipSuccess || per_cu < 1) { fprintf(stderr, "kernel_launch: occupancy query reports %d blocks per CU\n", per_cu); (void)hipGetLastError(); grid = -1; return; }
        grid = cus;
    }
    if (grid < 0) return;
    (void)hipMemsetAsync((char*)d_ws + WS_SS, 0, SS_BYTES, stream);
    Args a{};
    for (int i = 0; i < 14; ++i) a.in[i] = (const float*)d_in[i];
    a.out = (float*)d_out; a.ws = (unsigned char*)d_ws;
#if MK_N_LAUNCHES == 1
    a.ph_lo = 0; a.ph_hi = NPHASE;
    void* args[] = {&a};
    hipError_t e = hipLaunchCooperativeKernel((const void*)fwd_megakernel, dim3(grid), dim3(NTHR), args, LDS_BYTES, stream);
    if (e != hipSuccess) fprintf(stderr, "kernel_launch: cooperative launch failed: %s (grid %d)\n", hipGetErrorString(e), grid);
#else
    for (int ph = 0; ph < NPHASE; ++ph) { a.ph_lo = ph; a.ph_hi = ph + 1; hipLaunchKernelGGL(fwd_megakernel, dim3(grid), dim3(NTHR), LDS_BYTES, stream, a); }
#endif
}
```

```cpp
#include <hip/hip_runtime.h>
#include <hip/hip_cooperative_groups.h>
#include <cstdio>
#include <cstdint>
namespace cg = cooperative_groups;
namespace pg8 {
#define PG8_LAS __attribute__((address_space(3)))
typedef unsigned short bf16_t;
typedef short bf16x8 __attribute__((ext_vector_type(8)));
typedef float f32x4 __attribute__((ext_vector_type(4)));
typedef unsigned u32x4 __attribute__((ext_vector_type(4)));
constexpr int BM = 256, BK = 64, HALF = 128, HTB = HALF * BK * 2  , STAGE_BYTES = 8 * HTB, NXCD = 8, WGM = 8;

__host__ __device__ __forceinline__ int lds_byte(int r, int c) { const int st = (r >> 4) * 2 + (c >> 5), rr = r & 15, cc = c & 31, ob = rr * 64 + cc * 2; return st * 1024 + (ob ^ (((ob >> 9) & 1) << 5)); }
__host__ __device__ __forceinline__ void stage_rc(int b, int& R, int& C) { const int st = b / 1024, sb = b % 1024, swz = sb ^ (((sb >> 9) & 1) << 5); R = (st >> 1) * 16 + swz / 64; C = (st & 1) * 32 + (swz % 64) / 2; }
__host__ __device__ __forceinline__ int perm32(int rho) { const int n = rho >> 4, i = rho & 15; return 8 * (i >> 2) + 4 * n + (i & 3); }

struct Unit { int pm, pn; };
struct Gemm { const bf16_t* A; const bf16_t* Bt; int M, N, K; };

struct StaticOrder {
    int nM, nN, nwg, G, c;
    __host__ __device__ void init(int M, int N, int G_, int c_) { nM = M / BM; nN = N / BM; nwg = nM * nN; G = G_; c = c_; }
    __host__ __device__ bool next(int i, Unit& u) const {
        const long L = (long)i * G + c; if (L >= nwg) return false;
        int wgid = (int)L; { const int q = nwg / NXCD, r = nwg % NXCD, xcd = wgid % NXCD, off = wgid / NXCD; wgid = (xcd < r ? xcd * (q + 1) : r * (q + 1) + (xcd - r) * q) + off; }
        const int nig = WGM * nN, gid = wgid / nig, fm = gid * WGM, gsz = (nM - fm) < WGM ? (nM - fm) : WGM;
        u.pm = fm + ((wgid % nig) % gsz); u.pn = (wgid % nig) / gsz; return true;
    }
    __device__ __forceinline__ void a_ready(const Unit&) const {}
    __device__ __forceinline__ void done(const Unit&) const {}
};


__device__ __forceinline__ unsigned cvt_pk_bf16(float lo, float hi) { unsigned r; asm volatile("v_cvt_pk_bf16_f32 %0, %1, %2" : "=v"(r) : "v"(lo), "v"(hi)); return r; }
__device__ __forceinline__ float sigmoidf_fast(float z) { return __builtin_amdgcn_rcpf(1.0f + __expf(-z)); }
__device__ __forceinline__ float gelu_tanh(float x) { const float t = 1.5957691216057308f * (x + 0.044715f * x * x * x); return x * sigmoidf_fast(t); }

struct EpiIn {
    static constexpr bool PERM = true, AFTER_DRAIN = false;
    const float* rowss; const float* lb; bf16_t* U; bf16_t* V; bf16_t* Q; float* LF; bf16_t* I; bf16_t* G;
    __device__ __forceinline__ void operator()(const f32x4 (&acc)[2][2][4][2], const Unit& u, int wr, int wc, int fr, int fq) const {
        const int type = u.pn >> 1;
        const int row0 = u.pm * BM + wr * 64 + fr, cs = (u.pn & 1) * 256 + wc * 32 + 8 * fq;
        if (type == 3) {
            f32x4 l0[2], l1[2];
#pragma unroll
            for (int bj = 0; bj < 2; ++bj) { l0[bj] = *(const f32x4*)(lb + cs + bj * HALF); l1[bj] = *(const f32x4*)(lb + cs + bj * HALF + 4); }
#pragma unroll
            for (int ai = 0; ai < 2; ++ai)
#pragma unroll
                for (int m = 0; m < 4; ++m) { const int row = row0 + ai * HALF + m * 16; const float r = rsqrtf(rowss[row] * (1.0f / 1024.0f) + 1e-6f);
#pragma unroll
                    for (int bj = 0; bj < 2; ++bj) { f32x4 v0 = acc[ai][bj][m][0] * r, v1 = acc[ai][bj][m][1] * r;
#pragma unroll
                        for (int j = 0; j < 4; ++j) { v0[j] = __logf(l0[bj][j] + (1.0f - l0[bj][j]) * sigmoidf_fast(v0[j])); v1[j] = __logf(l1[bj][j] + (1.0f - l1[bj][j]) * sigmoidf_fast(v1[j])); }
                        float* p = LF + (size_t)row * 512 + cs + bj * HALF; *(f32x4*)p = v0; *(f32x4*)(p + 4) = v1; } }
        } else {
            bf16_t* ob = type == 0 ? U : type == 1 ? V : type == 2 ? Q : type == 4 ? I : G;
#pragma unroll
            for (int ai = 0; ai < 2; ++ai)
#pragma unroll
                for (int m = 0; m < 4; ++m) { const int row = row0 + ai * HALF + m * 16; const float r = rsqrtf(rowss[row] * (1.0f / 1024.0f) + 1e-6f);
#pragma unroll
                    for (int bj = 0; bj < 2; ++bj) { f32x4 v0 = acc[ai][bj][m][0] * r, v1 = acc[ai][bj][m][1] * r;
                        if (type <= 1) {
#pragma unroll
                            for (int j = 0; j < 4; ++j) { v0[j] = gelu_tanh(v0[j]); v1[j] = gelu_tanh(v1[j]); } }
                        else if (type == 5) {
#pragma unroll
                            for (int j = 0; j < 4; ++j) { v0[j] = v0[j] * sigmoidf_fast(v0[j]); v1[j] = v1[j] * sigmoidf_fast(v1[j]); } }
                        u32x4 w; w.x = cvt_pk_bf16(v0[0], v0[1]); w.y = cvt_pk_bf16(v0[2], v0[3]); w.z = cvt_pk_bf16(v1[0], v1[1]); w.w = cvt_pk_bf16(v1[2], v1[3]);
                        *(u32x4*)(ob + (size_t)row * 512 + cs + bj * HALF) = w; } }
        }
    }
};
struct EpiSq {
    static constexpr bool PERM = true, AFTER_DRAIN = false;
    const float* rowss; bf16_t* O; int ldc;
    __device__ __forceinline__ void operator()(const f32x4 (&acc)[2][2][4][2], const Unit& u, int wr, int wc, int fr, int fq) const {
        const int row0 = u.pm * BM + wr * 64 + fr, col0 = u.pn * BM + wc * 32 + 8 * fq;
#pragma unroll
        for (int ai = 0; ai < 2; ++ai)
#pragma unroll
            for (int m = 0; m < 4; ++m) { const int row = row0 + ai * HALF + m * 16; const float r = rsqrtf(rowss[row] * (1.0f / 1024.0f) + 1e-6f);
#pragma unroll
                for (int bj = 0; bj < 2; ++bj) { f32x4 v0 = acc[ai][bj][m][0] * r, v1 = acc[ai][bj][m][1] * r;
#pragma unroll
                    for (int j = 0; j < 4; ++j) { const float a = fmaxf(v0[j], 0.f), b = fmaxf(v1[j], 0.f); v0[j] = a * a; v1[j] = b * b; }
                    u32x4 w; w.x = cvt_pk_bf16(v0[0], v0[1]); w.y = cvt_pk_bf16(v0[2], v0[3]); w.z = cvt_pk_bf16(v1[0], v1[1]); w.w = cvt_pk_bf16(v1[2], v1[3]);
                    *(u32x4*)(O + (size_t)row * ldc + col0 + bj * HALF) = w; } }
    }
};
struct EpiRes {
    static constexpr bool PERM = true, AFTER_DRAIN = false;
    const float* xin; float* xout; bf16_t* xb; float* ss_out;
    __device__ __forceinline__ void operator()(const f32x4 (&acc)[2][2][4][2], const Unit& u, int wr, int wc, int fr, int fq) const {
        const int row0 = u.pm * BM + wr * 64 + fr, col0 = u.pn * BM + wc * 32 + 8 * fq;
#pragma unroll
        for (int ai = 0; ai < 2; ++ai)
#pragma unroll
            for (int m = 0; m < 4; ++m) { const int row = row0 + ai * HALF + m * 16; float ss = 0.f;
#pragma unroll
                for (int bj = 0; bj < 2; ++bj) { const size_t off = (size_t)row * 1024 + col0 + bj * HALF;
                    const f32x4 a0 = *(const f32x4*)(xin + off), a1 = *(const f32x4*)(xin + off + 4);
                    const f32x4 o0 = a0 + acc[ai][bj][m][0], o1 = a1 + acc[ai][bj][m][1];
                    *(f32x4*)(xout + off) = o0; *(f32x4*)(xout + off + 4) = o1;
                    u32x4 w; w.x = cvt_pk_bf16(o0[0], o0[1]); w.y = cvt_pk_bf16(o0[2], o0[3]); w.z = cvt_pk_bf16(o1[0], o1[1]); w.w = cvt_pk_bf16(o1[2], o1[3]);
                    *(u32x4*)(xb + off) = w;
                    ss += (o0[0] * o0[0] + o0[1] * o0[1]) + (o0[2] * o0[2] + o0[3] * o0[3]) + (o1[0] * o1[0] + o1[1] * o1[1]) + (o1[2] * o1[2] + o1[3] * o1[3]); }
                ss += __shfl_xor(ss, 16); ss += __shfl_xor(ss, 32);
                if (fq == 0) atomicAdd(ss_out + row, ss); }
    }
};

template <class Epi, class Sched, bool ALIGN_EPI = false, bool SP2 = false>
__device__ __forceinline__ void gemm_phase(PG8_LAS unsigned char* lds, const Gemm g, const Sched& S, const Epi& E) {
    int tid_ = threadIdx.x; asm volatile("" : "+v"(tid_));
    const int tid = tid_, wid = __builtin_amdgcn_readfirstlane(tid >> 6), lane = tid & 63, wr = wid >> 2, wc = wid & 3, fr = lane & 15, fq = lane >> 4;
    const int K = g.K, nt = K / BK;
    unsigned voffA[2], voffB[2];
#pragma unroll
    for (int i = 0; i < 2; ++i) { int R, C; stage_rc(tid * 16 + i * 8192, R, C); const int Rb = Epi::PERM ? ((R & ~31) + perm32(R & 31)) : R;
        voffA[i] = (unsigned)(R * K + C) * 2u; voffB[i] = (unsigned)(Rb * K + C) * 2u; }
    const size_t kstep = (size_t)(BK * 2);
    const size_t hstep = (size_t)HALF * K * 2;
    const size_t tstep = 2 * hstep;
    const unsigned ldsw = (unsigned)wid * 1024u;
    const int aoff = lds_byte(wr * 64 + fr, fq * 8), boff = lds_byte(wc * 32 + fr, fq * 8);
#define PG8_SA(b, h) (((b) * 2 + (h)) * HTB)
#define PG8_SB(b, h) ((4 + (b) * 2 + (h)) * HTB)
#define PG8_STAGE(bufoff, gbase, voff) do { _Pragma("unroll") for (int _i = 0; _i < 2; ++_i) \
        __builtin_amdgcn_global_load_lds((const unsigned*)((const char*)(gbase) + (voff)[_i]), (PG8_LAS unsigned*)(lds + (bufoff) + ldsw + _i * 8192), 16, 0, 0); } while (0)
#define PG8_LDA(dst, b, h) do { _Pragma("unroll") for (int m = 0; m < 4; ++m) _Pragma("unroll") for (int k = 0; k < 2; ++k) dst[m][k] = *(const PG8_LAS bf16x8*)(lds + PG8_SA(b, h) + aoff + m * 2048 + k * 1024); } while (0)
#define PG8_LDB(dst, b, h) do { _Pragma("unroll") for (int n = 0; n < 2; ++n) _Pragma("unroll") for (int k = 0; k < 2; ++k) dst[n][k] = *(const PG8_LAS bf16x8*)(lds + PG8_SB(b, h) + boff + n * 2048 + k * 1024); } while (0)
#define PG8_MMA(ai, bj, At, Bt) do { __builtin_amdgcn_s_setprio(1); _Pragma("unroll") for (int m = 0; m < 4; ++m) _Pragma("unroll") for (int n = 0; n < 2; ++n) _Pragma("unroll") for (int k = 0; k < 2; ++k) \
        acc[ai][bj][m][n] = __builtin_amdgcn_mfma_f32_16x16x32_bf16(Bt[n][k], At[m][k], acc[ai][bj][m][n], 0, 0, 0); __builtin_amdgcn_s_setprio(0); } while (0)
#define PG8_WAIT_V(n) asm volatile("s_waitcnt vmcnt(" #n ")" ::: "memory")
#define PG8_WAIT_L(n) asm volatile("s_waitcnt lgkmcnt(" #n ")" ::: "memory")
#define PG8_BAR __builtin_amdgcn_s_barrier()
#define PG8_SCHED __builtin_amdgcn_sched_barrier(0)
    Unit cur, nxt; int ui = 0;
    if (!S.next(0, cur)) return;
    f32x4 acc[2][2][4][2];
#pragma unroll
    for (int a = 0; a < 2; ++a)
#pragma unroll
        for (int b = 0; b < 2; ++b)
#pragma unroll
            for (int m = 0; m < 4; ++m)
#pragma unroll
                for (int n = 0; n < 2; ++n) acc[a][b][m][n] = (f32x4){0.f, 0.f, 0.f, 0.f};
    bf16x8 At[4][2], B0[2][2], B1[2][2];
    const char* cA = (const char*)g.A + (size_t)cur.pm * tstep; const char* cB = (const char*)g.Bt + (size_t)cur.pn * tstep;
    S.a_ready(cur);
    if constexpr (SP2) {
        PG8_STAGE(PG8_SB(0, 0), cB, voffB); PG8_STAGE(PG8_SB(0, 1), cB + hstep, voffB); PG8_STAGE(PG8_SA(0, 0), cA, voffA); PG8_STAGE(PG8_SA(0, 1), cA + hstep, voffA);
        if (wr == 1) PG8_BAR;
        PG8_WAIT_V(2); PG8_BAR;
        PG8_STAGE(PG8_SB(1, 0), cB + kstep, voffB); PG8_STAGE(PG8_SA(1, 0), cA + kstep, voffA); PG8_STAGE(PG8_SB(1, 1), cB + hstep + kstep, voffB);
        PG8_WAIT_V(6); PG8_BAR;
    } else {
        PG8_STAGE(PG8_SB(0, 0), cB, voffB); PG8_STAGE(PG8_SA(0, 0), cA, voffA); PG8_STAGE(PG8_SB(0, 1), cB + hstep, voffB); PG8_STAGE(PG8_SA(0, 1), cA + hstep, voffA);
        if (wr == 1) PG8_BAR;
        PG8_WAIT_V(4); PG8_BAR;
        PG8_STAGE(PG8_SB(1, 0), cB + kstep, voffB); PG8_STAGE(PG8_SA(1, 0), cA + kstep, voffA); PG8_STAGE(PG8_SB(1, 1), cB + hstep + kstep, voffB);
        PG8_WAIT_V(6); PG8_BAR;
    }
    for (;;) {
        const bool has_next = S.next(ui + 1, nxt);
        const char* nA = has_next ? (const char*)g.A + (size_t)nxt.pm * tstep : cA; const char* nB = has_next ? (const char*)g.Bt + (size_t)nxt.pn * tstep : cB;
        for (int t = 0; t < nt; t += 2) {
            const bool last = (t == nt - 2);
            const char* a1 = cA + (size_t)(t + 1) * kstep;
            const char* a2 = last ? nA : cA + (size_t)(t + 2) * kstep; const char* b2 = last ? nB : cB + (size_t)(t + 2) * kstep;
            const char* a3 = a2 + kstep; const char* b3 = b2 + kstep;
            if (last && has_next) S.a_ready(nxt);
            if constexpr (SP2) {
            PG8_LDB(B0, 0, 0); PG8_LDB(B1, 0, 1); PG8_SCHED; PG8_LDA(At, 0, 0); PG8_STAGE(PG8_SA(1, 1), a1 + hstep, voffA);
            PG8_WAIT_V(8); PG8_WAIT_L(0); PG8_BAR; PG8_MMA(0, 0, At, B0); PG8_MMA(0, 1, At, B1); PG8_BAR; PG8_SCHED;
            PG8_LDA(At, 0, 1); PG8_STAGE(PG8_SB(0, 0), b2, voffB); PG8_STAGE(PG8_SB(0, 1), b2 + hstep, voffB); PG8_STAGE(PG8_SA(0, 0), a2, voffA);
            PG8_WAIT_V(8); PG8_WAIT_L(0); PG8_BAR; PG8_MMA(1, 0, At, B0); PG8_MMA(1, 1, At, B1); PG8_BAR; PG8_SCHED;
            PG8_LDB(B0, 1, 0); PG8_LDB(B1, 1, 1); PG8_SCHED; PG8_LDA(At, 1, 0); PG8_STAGE(PG8_SA(0, 1), a2 + hstep, voffA);
            PG8_WAIT_V(8); PG8_WAIT_L(0); PG8_BAR; PG8_MMA(0, 0, At, B0); PG8_MMA(0, 1, At, B1); PG8_BAR; PG8_SCHED;
            PG8_LDA(At, 1, 1); PG8_STAGE(PG8_SB(1, 0), b3, voffB); PG8_STAGE(PG8_SB(1, 1), b3 + hstep, voffB); PG8_STAGE(PG8_SA(1, 0), a3, voffA);
            PG8_WAIT_V(8); PG8_WAIT_L(0); PG8_BAR; PG8_MMA(1, 0, At, B0); PG8_MMA(1, 1, At, B1); PG8_BAR; PG8_SCHED;
            } else {
            PG8_LDB(B0, 0, 0); PG8_SCHED; PG8_LDA(At, 0, 0); PG8_STAGE(PG8_SA(1, 1), a1 + hstep, voffA);
            PG8_WAIT_L(8); PG8_BAR; PG8_WAIT_L(0); PG8_MMA(0, 0, At, B0); PG8_BAR; PG8_SCHED;
            PG8_LDB(B1, 0, 1); PG8_STAGE(PG8_SB(0, 0), b2, voffB);
            PG8_BAR; PG8_WAIT_L(0); PG8_MMA(0, 1, At, B1); PG8_BAR;
            PG8_LDA(At, 0, 1); PG8_STAGE(PG8_SA(0, 0), a2, voffA);
            PG8_BAR; PG8_WAIT_L(0); PG8_MMA(1, 0, At, B0); PG8_BAR; PG8_SCHED;
            PG8_STAGE(PG8_SB(0, 1), b2 + hstep, voffB);
            PG8_WAIT_V(6); PG8_BAR; PG8_MMA(1, 1, At, B1); PG8_BAR;
            PG8_LDB(B0, 1, 0); PG8_SCHED; PG8_LDA(At, 1, 0); PG8_STAGE(PG8_SA(0, 1), a2 + hstep, voffA);
            PG8_WAIT_L(8); PG8_BAR; PG8_WAIT_L(0); PG8_MMA(0, 0, At, B0); PG8_BAR; PG8_SCHED;
            PG8_LDB(B1, 1, 1); PG8_STAGE(PG8_SB(1, 0), b3, voffB);
            PG8_BAR; PG8_WAIT_L(0); PG8_MMA(0, 1, At, B1); PG8_BAR;
            PG8_LDA(At, 1, 1); PG8_STAGE(PG8_SA(1, 0), a3, voffA);
            PG8_BAR; PG8_WAIT_L(0); PG8_MMA(1, 0, At, B0); PG8_BAR; PG8_SCHED;
            PG8_STAGE(PG8_SB(1, 1), b3 + hstep, voffB);
            PG8_WAIT_V(6); PG8_BAR; PG8_MMA(1, 1, At, B1); PG8_BAR;
            }
        }
        if constexpr (ALIGN_EPI) { if (wr == 0) PG8_BAR; }
        if constexpr (!Epi::AFTER_DRAIN) { E(acc, cur, wr, wc, fr, fq); S.done(cur); }
        if (!has_next) break;
#pragma unroll
        for (int a = 0; a < 2; ++a)
#pragma unroll
            for (int b = 0; b < 2; ++b)
#pragma unroll
                for (int m = 0; m < 4; ++m)
#pragma unroll
                    for (int n = 0; n < 2; ++n) acc[a][b][m][n] = (f32x4){0.f, 0.f, 0.f, 0.f};
        cur = nxt; cA = nA; cB = nB; ++ui;
        if constexpr (ALIGN_EPI) { if (wr == 1) PG8_BAR; }
    }
    PG8_WAIT_V(0);
    if constexpr (!ALIGN_EPI) { if (wr == 0) PG8_BAR; }
    PG8_BAR;
    if constexpr (Epi::AFTER_DRAIN) { E.fused(acc, cur, wr, wc, fr, fq, lds, wid, lane); S.done(cur); }
#undef PG8_SA
#undef PG8_SB
#undef PG8_STAGE
#undef PG8_LDA
#undef PG8_LDB
#undef PG8_MMA
#undef PG8_WAIT_V
#undef PG8_WAIT_L
#undef PG8_BAR
#undef PG8_SCHED
}
}

#ifndef MK_N_LAUNCHES
#define MK_N_LAUNCHES 1
#endif
#ifndef REP_MIX
#define REP_MIX 1
#endif
#ifndef REP_G13
#define REP_G13 1
#endif
#ifndef REP_SYNC
#define REP_SYNC 1
#endif
#ifndef REP_P0
#define REP_P0 1
#endif
constexpr int NWAVES = 8, NTHR = 512;
constexpr int M = 16384, D = 1024, DIN = 3072, DFF = 4096, SEQ = 4096;
constexpr int NPHASE = 14;
constexpr float EPS = 1e-6f;
constexpr size_t MiB = 1u << 20;
constexpr size_t WS_SS = 0, SS_BYTES = 5 * (size_t)M * 4;
constexpr size_t WS_BAR = 384 * 1024;
constexpr size_t CTL_ZERO_BYTES = 448 * 1024;
constexpr size_t WS_LB = 512 * 1024;
constexpr size_t WS_W = 1 * MiB, W_LAYER = 24 * MiB, W_IN = 0, W_OUT = 6 * MiB, W_UP = 8 * MiB, W_DOWN = 16 * MiB;
constexpr size_t WS_XB = 49 * MiB;
constexpr size_t WS_H = 81 * MiB;
constexpr size_t WS_U = 81 * MiB, WS_V = 97 * MiB, WS_Q = 113 * MiB, WS_LF = 129 * MiB, WS_I = 161 * MiB, WS_G = 177 * MiB, WS_Y = 193 * MiB, WS_SLOC = 225 * MiB, WS_DTOT = 241 * MiB;
constexpr size_t WS_END = 242 * MiB;
constexpr int LDS_BYTES = 147456;

#define LAS __attribute__((address_space(3)))
typedef unsigned short bf16;
typedef unsigned v4u __attribute__((ext_vector_type(4)));
typedef unsigned v2u __attribute__((ext_vector_type(2)));
typedef float f32x4 __attribute__((ext_vector_type(4)));
typedef float f32x16 __attribute__((ext_vector_type(16)));
typedef short bf16x8 __attribute__((ext_vector_type(8)));
#define LDS_WAIT() asm volatile("s_waitcnt lgkmcnt(0)" ::: "memory")
__device__ __forceinline__ unsigned pkbf(float lo, float hi) { return pg8::cvt_pk_bf16(lo, hi); }
__device__ __forceinline__ float bf_lo(unsigned w) { return __uint_as_float(w << 16); }
__device__ __forceinline__ float bf_hi(unsigned w) { return __uint_as_float(w & 0xffff0000u); }
__device__ __forceinline__ float bf1(bf16 v) { return __uint_as_float(((unsigned)v) << 16); }
__device__ __forceinline__ bf16 tobf(float f) { return (bf16)(pg8::cvt_pk_bf16(f, 0.f) & 0xffffu); }
__device__ __forceinline__ float wave_sum(float v) {
#pragma unroll
    for (int o = 1; o < 64; o <<= 1) v += __shfl_xor(v, o);
    return v;
}

__device__ __forceinline__ void p0_transpose_item(const float* W, int K, int N, bf16* WT, const float* ksc, LAS float* scr, int item, int lane) {
    const int nblk = N / 32, kb = item / nblk, nb = item % nblk, k0 = 64 * kb, n0 = 32 * nb;
#pragma unroll 8
    for (int i = 0; i < 32; ++i) { const int kk = 2 * i + (lane >> 5); const float s = ksc ? ksc[k0 + kk] : 1.0f; scr[kk * 33 + (lane & 31)] = W[(size_t)(k0 + kk) * N + n0 + (lane & 31)] * s; }
    LDS_WAIT(); asm volatile("" ::: "memory");
    const int c = lane & 7;
#pragma unroll
    for (int j = 0; j < 4; ++j) { const int n = (lane >> 3) + 8 * j; const LAS float* s = scr + (8 * c) * 33 + n;
        v4u o; o.x = pkbf(s[0 * 33], s[1 * 33]); o.y = pkbf(s[2 * 33], s[3 * 33]); o.z = pkbf(s[4 * 33], s[5 * 33]); o.w = pkbf(s[6 * 33], s[7 * 33]);
        *(v4u*)(WT + (size_t)(n0 + n) * K + k0 + 8 * c) = o; }
    LDS_WAIT(); asm volatile("" ::: "memory");
}

struct Args { const float* in[14]; float* out; unsigned char* ws; int ph_lo, ph_hi; };

__device__ __forceinline__ void p0_prologue(const Args& a, LAS unsigned char* lds, int tid_) {
    int tid = tid_; asm volatile("" : "+v"(tid));
    const int lane = tid & 63, wave = tid >> 6;
    LAS float* scr = (LAS float*)(lds + wave * 16384);
    const int gw = blockIdx.x * NWAVES + wave, NGW = gridDim.x * NWAVES;
    constexpr int I_IN = (D / 64) * (DIN / 32), I_OUT = (D / 64) * (D / 32), I_UP = (D / 64) * (DFF / 32), I_DN = (DFF / 64) * (D / 32), I_L = I_IN + I_OUT + I_UP + I_DN;
    for (int it = gw; it < 2 * I_L; it += NGW) {
        const int l = it / I_L; int r = it % I_L;
        unsigned char* wl = a.ws + WS_W + (size_t)l * W_LAYER;
        if (r < I_IN) { p0_transpose_item(a.in[2] + (size_t)l * D * DIN, D, DIN, (bf16*)(wl + W_IN), a.in[1] + l * D, scr, r, lane); continue; } r -= I_IN;
        if (r < I_OUT) { p0_transpose_item(a.in[9] + (size_t)l * D * D, D, D, (bf16*)(wl + W_OUT), nullptr, scr, r, lane); continue; } r -= I_OUT;
        if (r < I_UP) { p0_transpose_item(a.in[11] + (size_t)l * D * DFF, D, DFF, (bf16*)(wl + W_UP), a.in[10] + l * D, scr, r, lane); continue; } r -= I_UP;
        p0_transpose_item(a.in[12] + (size_t)l * DFF * D, DFF, D, (bf16*)(wl + W_DOWN), nullptr, scr, r, lane);
    }
    bf16* XB = (bf16*)(a.ws + WS_XB); float* ss0 = (float*)(a.ws + WS_SS);
    for (int m = gw; m < M; m += NGW) {
        const f32x4* xr = (const f32x4*)(a.in[0] + (size_t)m * D) + lane; float s = 0.f;
        unsigned long long* o8 = (unsigned long long*)(XB + (size_t)m * D) + lane;
#pragma unroll
        for (int j = 0; j < 4; ++j) { const f32x4 v = xr[64 * j]; s += (v.x * v.x + v.y * v.y) + (v.z * v.z + v.w * v.w);
            o8[64 * j] = (unsigned long long)pkbf(v.x, v.y) | ((unsigned long long)pkbf(v.z, v.w) << 32); }
        s = wave_sum(s);
        if (lane == 0) ss0[m] = s;
    }
    if (blockIdx.x == 0) { float* lbv = (float*)(a.ws + WS_LB); const float* lw = a.in[7];
        for (int c = tid; c < 512; c += NTHR) { const float a0 = lw[c], a1 = lw[512 + c]; lbv[c] = 0.f; lbv[512 + c] = 1.0f / (1.0f + expf(a0 - a1)); } }
}

__device__ __forceinline__ void gmlp_item(LAS unsigned char* lds, int item, const bf16* U, const bf16* V, const float* Wsp, const float* bsp, const float* gv, const float* go, bf16* Y, int tid_) {
    int tid = tid_; asm volatile("" : "+v"(tid));
    const int g = item & 3, row0 = (item >> 2) * 128;
    const int lane = tid & 63, w = tid >> 6, r = lane & 31, hh = lane >> 5;
    LAS unsigned char* VnT = lds; LAS float* red = (LAS float*)(lds + 34816); LAS float* ssqb = (LAS float*)(lds + 38912);
    __syncthreads();
    {
        const int sp = lane, cr = w;
        const bf16* vp = V + (size_t)(row0 + 2 * sp) * 512 + g * 128 + cr * 16;
        const v4u a0 = *(const v4u*)vp, a1 = *(const v4u*)(vp + 8), b0 = *(const v4u*)(vp + 512), b1 = *(const v4u*)(vp + 520);
        float va[16], vb[16];
#pragma unroll
        for (int j = 0; j < 4; ++j) { va[2 * j] = bf_lo(a0[j]); va[2 * j + 1] = bf_hi(a0[j]); va[8 + 2 * j] = bf_lo(a1[j]); va[9 + 2 * j] = bf_hi(a1[j]);
            vb[2 * j] = bf_lo(b0[j]); vb[2 * j + 1] = bf_hi(b0[j]); vb[8 + 2 * j] = bf_lo(b1[j]); vb[9 + 2 * j] = bf_hi(b1[j]); }
        float sa = 0.f, sb = 0.f;
#pragma unroll
        for (int j = 0; j < 16; ++j) { sa += va[j] * va[j]; sb += vb[j] * vb[j]; }
        red[cr * 128 + 2 * sp] = sa; red[cr * 128 + 2 * sp + 1] = sb;
        __syncthreads();
        float ta = 0.f, tb = 0.f;
#pragma unroll
        for (int k = 0; k < 8; ++k) { ta += red[k * 128 + 2 * sp]; tb += red[k * 128 + 2 * sp + 1]; }
        const float ra = rsqrtf(ta * (1.0f / 128.0f) + EPS), rb = rsqrtf(tb * (1.0f / 128.0f) + EPS);
#pragma unroll
        for (int j = 0; j < 16; ++j) { const int c = cr * 16 + j; const float gw = gv[g * 128 + c];
            *(LAS unsigned*)(VnT + c * 272 + sp * 4) = pkbf(va[j] * ra * gw, vb[j] * rb * gw); }
    }
    __syncthreads();
    const int cb = w >> 1;
    f32x16 acc[2]; float yv[2][16];
#pragma unroll
    for (int x = 0; x < 2; ++x) {
        const int tb = (w & 1) ? (x == 0 ? 1 : 2) : (x == 0 ? 0 : 3);
        const int t = tb * 32 + r;
#pragma unroll
        for (int q = 0; q < 16; ++q) acc[x][q] = 0.f;
        const float* wrow = Wsp + (size_t)(g * 128 + t) * 128 + 8 * hh;
        const int nks = (tb + 1) * 2;
        for (int ks = 0; ks < nks; ++ks) {
            const bf16x8 af = *(const LAS bf16x8*)(VnT + (cb * 32 + r) * 272 + (ks * 16 + 8 * hh) * 2);
            const f32x4 w0 = *(const f32x4*)(wrow + ks * 16), w1 = *(const f32x4*)(wrow + ks * 16 + 4);
            const int s0 = ks * 16 + 8 * hh;
            float e[8] = {w0[0], w0[1], w0[2], w0[3], w1[0], w1[1], w1[2], w1[3]};
#pragma unroll
            for (int j = 0; j < 8; ++j) e[j] = (s0 + j <= t) ? e[j] : 0.f;
            v4u bw; bw.x = pkbf(e[0], e[1]); bw.y = pkbf(e[2], e[3]); bw.z = pkbf(e[4], e[5]); bw.w = pkbf(e[6], e[7]);
            acc[x] = __builtin_amdgcn_mfma_f32_32x32x16_bf16(af, __builtin_bit_cast(bf16x8, bw), acc[x], 0, 0, 0);
        }
        const float bias = bsp[g * 128 + t]; float ssq = 0.f;
#pragma unroll
        for (int i = 0; i < 4; ++i) { const int c = cb * 32 + 8 * i + 4 * hh;
            const v2u uw = *(const v2u*)(U + (size_t)(row0 + t) * 512 + g * 128 + c);
            const float u0 = bf_lo(uw.x), u1 = bf_hi(uw.x), u2 = bf_lo(uw.y), u3 = bf_hi(uw.y);
            yv[x][4 * i + 0] = u0 * (acc[x][4 * i + 0] + bias); yv[x][4 * i + 1] = u1 * (acc[x][4 * i + 1] + bias);
            yv[x][4 * i + 2] = u2 * (acc[x][4 * i + 2] + bias); yv[x][4 * i + 3] = u3 * (acc[x][4 * i + 3] + bias);
#pragma unroll
            for (int j = 0; j < 4; ++j) ssq += yv[x][4 * i + j] * yv[x][4 * i + j]; }
        ssq += __shfl_xor(ssq, 32);
        if (hh == 0) ssqb[cb * 128 + t] = ssq;
    }
    __syncthreads();
#pragma unroll
    for (int x = 0; x < 2; ++x) {
        const int tb = (w & 1) ? (x == 0 ? 1 : 2) : (x == 0 ? 0 : 3);
        const int t = tb * 32 + r;
        const float tot = (ssqb[t] + ssqb[128 + t]) + (ssqb[256 + t] + ssqb[384 + t]);
        const float rs = rsqrtf(tot * (1.0f / 128.0f) + EPS);
#pragma unroll
        for (int i = 0; i < 4; ++i) { const int c = cb * 32 + 8 * i + 4 * hh; const f32x4 gw = *(const f32x4*)(go + g * 128 + c);
            v2u o; o.x = pkbf(yv[x][4 * i] * rs * gw[0], yv[x][4 * i + 1] * rs * gw[1]); o.y = pkbf(yv[x][4 * i + 2] * rs * gw[2], yv[x][4 * i + 3] * rs * gw[3]);
            *(v2u*)(Y + (size_t)(row0 + t) * 1024 + g * 128 + c) = o; }
    }
}

template <bool OUT>
__device__ __forceinline__ void hgrn_item(LAS unsigned char* lds, int item, const bf16* Q, const float* LF, const bf16* I, const bf16* G, const float* gbo, float* SLOC, float* DTOT, bf16* Y, int tid_) {
    int tid = tid_; asm volatile("" : "+v"(tid));
    const int sc = item & 15, bh = item >> 4, b = bh >> 2, h = bh & 3;
    const int rowbase = b * SEQ + sc * 256;
    const int lane = tid & 63, w = tid >> 6, r = lane & 31, hh = lane >> 5;
    LAS unsigned char* Q1s = lds; LAS unsigned char* K1s = lds + 17408; LAS unsigned char* K2T = lds + 34816; LAS unsigned char* VT = lds + 53248;
    LAS unsigned char* ST = lds + 71680; LAS unsigned char* Ps = lds + 106496;
    LAS float* totb = (LAS float*)(lds + 115712); LAS float* dl = (LAS float*)(lds + 117760); LAS float* ssqb = (LAS float*)(lds + 118272);
    const int kb = w >> 1, vb0 = (w & 1) * 2;
    const int vb = w >> 1, tb = w & 1;
    f32x16 S[2];
#pragma unroll
    for (int x = 0; x < 2; ++x)
#pragma unroll
        for (int q = 0; q < 16; ++q) S[x][q] = 0.f;
    __syncthreads();
    if (OUT) {
        for (int m = 0; m < sc; ++m) {
            const float* dt = DTOT + (size_t)(bh * 16 + m) * 128; const float* sl = SLOC + (size_t)(bh * 16 + m) * 16384;
#pragma unroll
            for (int i = 0; i < 4; ++i) { const int k0 = kb * 32 + 8 * i + 4 * hh; const f32x4 d4 = *(const f32x4*)(dt + k0);
#pragma unroll
                for (int x = 0; x < 2; ++x)
#pragma unroll
                    for (int j = 0; j < 4; ++j) S[x][4 * i + j] = d4[j] * S[x][4 * i + j] + sl[(size_t)(k0 + j) * 128 + (vb0 + x) * 32 + r]; }
        }
#pragma unroll
        for (int x = 0; x < 2; ++x)
#pragma unroll
            for (int i = 0; i < 4; ++i) { v2u o; o.x = pkbf(S[x][4 * i], S[x][4 * i + 1]); o.y = pkbf(S[x][4 * i + 2], S[x][4 * i + 3]);
                *(LAS v2u*)(ST + ((vb0 + x) * 32 + r) * 272 + (kb * 32 + 8 * i + 4 * hh) * 2) = o; }
    }
    const int ch = tid & 127, part = tid >> 7;
    float btot = 0.f;
    for (int jc = 0; jc < 4; ++jc) {
        const int row0 = rowbase + jc * 64;
        float cs[16]; unsigned short iv[16], qv[16];
        {
            const size_t e0 = (size_t)(row0 + part * 16) * 512 + h * 128 + ch;
#pragma unroll
            for (int i = 0; i < 16; ++i) { cs[i] = LF[e0 + (size_t)i * 512]; iv[i] = I[e0 + (size_t)i * 512]; if (OUT) qv[i] = Q[e0 + (size_t)i * 512]; }
        }
        float lfv[16];
#pragma unroll
        for (int i = 0; i < 16; ++i) lfv[i] = cs[i];
#pragma unroll
        for (int i = 1; i < 16; ++i) cs[i] += cs[i - 1];
        totb[part * 128 + ch] = cs[15];
        __syncthreads();
        const float t0 = totb[ch], t1 = totb[128 + ch], t2 = totb[256 + ch], t3 = totb[384 + ch];
        const float off = (part > 0 ? t0 : 0.f) + (part > 1 ? t1 : 0.f) + (part > 2 ? t2 : 0.f);
        const float bl = (t0 + t1) + (t2 + t3);
        {
            unsigned k2w[8], vw[8];
#pragma unroll
            for (int i = 0; i < 16; i += 2) {
                const float b0 = off + cs[i], b1 = off + cs[i + 1];
                const float k0 = 1.0f - __expf(lfv[i]), k1 = 1.0f - __expf(lfv[i + 1]);
                k2w[i >> 1] = pkbf(k0 * __expf(bl - b0), k1 * __expf(bl - b1));
                vw[i >> 1] = (unsigned)iv[i] | ((unsigned)iv[i + 1] << 16);
                if (OUT) {
                    const float q0 = bf1(qv[i]) * __expf(b0), q1 = bf1(qv[i + 1]) * __expf(b1);
                    const float c0 = k0 * __expf(fminf(-b0, 80.f)), c1 = k1 * __expf(fminf(-b1, 80.f));
                    *(LAS bf16*)(Q1s + (part * 16 + i) * 272 + ch * 2) = tobf(q0); *(LAS bf16*)(Q1s + (part * 16 + i + 1) * 272 + ch * 2) = tobf(q1);
                    *(LAS bf16*)(K1s + (part * 16 + i) * 272 + ch * 2) = tobf(c0); *(LAS bf16*)(K1s + (part * 16 + i + 1) * 272 + ch * 2) = tobf(c1);
                }
            }
            *(LAS v4u*)(K2T + ch * 144 + part * 32) = (v4u){k2w[0], k2w[1], k2w[2], k2w[3]}; *(LAS v4u*)(K2T + ch * 144 + part * 32 + 16) = (v4u){k2w[4], k2w[5], k2w[6], k2w[7]};
            *(LAS v4u*)(VT + ch * 144 + part * 32) = (v4u){vw[0], vw[1], vw[2], vw[3]}; *(LAS v4u*)(VT + ch * 144 + part * 32 + 16) = (v4u){vw[4], vw[5], vw[6], vw[7]};
            if (part == 0) { dl[ch] = __expf(bl); btot += bl; }
        }
        __syncthreads();
        f32x16 accO;
#pragma unroll
        for (int q = 0; q < 16; ++q) accO[q] = 0.f;
        if (OUT) {
            if (w < 3) {
                const int sb = (w == 2) ? 1 : 0, tbs = (w == 0) ? 0 : 1;
                f32x16 sa;
#pragma unroll
                for (int q = 0; q < 16; ++q) sa[q] = 0.f;
#pragma unroll
                for (int ks = 0; ks < 8; ++ks) {
                    const bf16x8 af = *(const LAS bf16x8*)(K1s + (sb * 32 + r) * 272 + (ks * 16 + 8 * hh) * 2);
                    const bf16x8 bfr = *(const LAS bf16x8*)(Q1s + (tbs * 32 + r) * 272 + (ks * 16 + 8 * hh) * 2);
                    sa = __builtin_amdgcn_mfma_f32_32x32x16_bf16(af, bfr, sa, 0, 0, 0);
                }
                const int t = tbs * 32 + r;
#pragma unroll
                for (int i = 0; i < 4; ++i) { const int s0 = sb * 32 + 8 * i + 4 * hh;
                    const float p0 = (s0 + 0 <= t) ? sa[4 * i + 0] : 0.f, p1 = (s0 + 1 <= t) ? sa[4 * i + 1] : 0.f, p2 = (s0 + 2 <= t) ? sa[4 * i + 2] : 0.f, p3 = (s0 + 3 <= t) ? sa[4 * i + 3] : 0.f;
                    v2u o; o.x = pkbf(p0, p1); o.y = pkbf(p2, p3);
                    *(LAS v2u*)(Ps + t * 144 + s0 * 2) = o; }
            }
#pragma unroll
            for (int ks = 0; ks < 8; ++ks) {
                const bf16x8 af = *(const LAS bf16x8*)(ST + (vb * 32 + r) * 272 + (ks * 16 + 8 * hh) * 2);
                const bf16x8 bfr = *(const LAS bf16x8*)(Q1s + (tb * 32 + r) * 272 + (ks * 16 + 8 * hh) * 2);
                accO = __builtin_amdgcn_mfma_f32_32x32x16_bf16(af, bfr, accO, 0, 0, 0);
            }
            __syncthreads();
            const int nks = (tb + 1) * 2;
            for (int ks = 0; ks < nks; ++ks) {
                const bf16x8 af = *(const LAS bf16x8*)(VT + (vb * 32 + r) * 144 + (ks * 16 + 8 * hh) * 2);
                const bf16x8 bfr = *(const LAS bf16x8*)(Ps + (tb * 32 + r) * 144 + (ks * 16 + 8 * hh) * 2);
                accO = __builtin_amdgcn_mfma_f32_32x32x16_bf16(af, bfr, accO, 0, 0, 0);
            }
        }
        if (!OUT || jc < 3) {
#pragma unroll
            for (int i = 0; i < 4; ++i) { const f32x4 d4 = *(const LAS f32x4*)(dl + kb * 32 + 8 * i + 4 * hh);
#pragma unroll
                for (int x = 0; x < 2; ++x)
#pragma unroll
                    for (int j = 0; j < 4; ++j) S[x][4 * i + j] *= d4[j]; }
#pragma unroll
            for (int ks = 0; ks < 4; ++ks) {
                const bf16x8 af = *(const LAS bf16x8*)(K2T + (kb * 32 + r) * 144 + (ks * 16 + 8 * hh) * 2);
#pragma unroll
                for (int x = 0; x < 2; ++x) {
                    const bf16x8 bfr = *(const LAS bf16x8*)(VT + ((vb0 + x) * 32 + r) * 144 + (ks * 16 + 8 * hh) * 2);
                    S[x] = __builtin_amdgcn_mfma_f32_32x32x16_bf16(af, bfr, S[x], 0, 0, 0);
                }
            }
            if (OUT) {
#pragma unroll
                for (int x = 0; x < 2; ++x)
#pragma unroll
                    for (int i = 0; i < 4; ++i) { v2u o; o.x = pkbf(S[x][4 * i], S[x][4 * i + 1]); o.y = pkbf(S[x][4 * i + 2], S[x][4 * i + 3]);
                        *(LAS v2u*)(ST + ((vb0 + x) * 32 + r) * 272 + (kb * 32 + 8 * i + 4 * hh) * 2) = o; }
            }
        }
        if (OUT) {
            float ssq = 0.f;
#pragma unroll
            for (int q = 0; q < 16; ++q) ssq += accO[q] * accO[q];
            ssq += __shfl_xor(ssq, 32);
            if (hh == 0) ssqb[vb * 64 + tb * 32 + r] = ssq;
        }
        __syncthreads();
        if (OUT) {
            const int tl = tb * 32 + r;
            const float tot = (ssqb[tl] + ssqb[64 + tl]) + (ssqb[128 + tl] + ssqb[192 + tl]);
            const float rs = rsqrtf(tot * (1.0f / 128.0f) + EPS);
#pragma unroll
            for (int i = 0; i < 4; ++i) { const int v0 = vb * 32 + 8 * i + 4 * hh;
                const v2u gw = *(const v2u*)(G + (size_t)(row0 + tl) * 512 + h * 128 + v0); const f32x4 nw = *(const f32x4*)(gbo + h * 128 + v0);
                v2u o; o.x = pkbf(accO[4 * i] * rs * nw[0] * bf_lo(gw.x), accO[4 * i + 1] * rs * nw[1] * bf_hi(gw.x));
                o.y = pkbf(accO[4 * i + 2] * rs * nw[2] * bf_lo(gw.y), accO[4 * i + 3] * rs * nw[3] * bf_hi(gw.y));
                *(v2u*)(Y + (size_t)(row0 + tl) * 1024 + 512 + h * 128 + v0) = o; }
        }
    }
    if (!OUT) {
        float* sl = SLOC + (size_t)(bh * 16 + sc) * 16384;
#pragma unroll
        for (int x = 0; x < 2; ++x)
#pragma unroll
            for (int q = 0; q < 16; ++q) { const int k = kb * 32 + (q & 3) + 8 * (q >> 2) + 4 * hh; sl[(size_t)k * 128 + (vb0 + x) * 32 + r] = S[x][q]; }
        if (part == 0) DTOT[(size_t)(bh * 16 + sc) * 128 + ch] = __expf(btot);
    }
}

#define RLX_AGENT __ATOMIC_RELAXED, __HIP_MEMORY_SCOPE_AGENT
#define XB_TMO      128
#define XB_XCNT(j)  (256  + 64 * (j))
#define XB_XSUB(j)  (1280 + 64 * (j))
#define XB_XGEN(j)  (2304 + 64 * (j))
#define XB_TOP      3328
#define XB_TOPGEN   3392
#define XCD_BAR_WORDS 3456
#define XB_SPIN_CAP (1u << 18)

__device__ __forceinline__ unsigned xb_ld(unsigned* p)              { return __hip_atomic_load(p, __ATOMIC_RELAXED, __HIP_MEMORY_SCOPE_AGENT); }
__device__ __forceinline__ unsigned xb_add(unsigned* p, unsigned v) { return __hip_atomic_fetch_add(p, v, __ATOMIC_RELAXED, __HIP_MEMORY_SCOPE_AGENT); }
__device__ __forceinline__ unsigned xb_xcc_id() { return (unsigned)__builtin_amdgcn_s_getreg((3 << 11) | 20) & 0xFu; }
#define XB_SPIN(cond, bar) do { unsigned _sp = 0; while (cond) { __builtin_amdgcn_s_sleep(1); \
    if ((++_sp & 255u) == 0u) { if (xb_ld(&(bar)[XB_TMO])) break; if (_sp > XB_SPIN_CAP) { atomicAdd(&(bar)[XB_TMO], 1u); break; } } } } while (0)

struct XcdBarrier {
    unsigned* bar; unsigned x;
    volatile LAS unsigned* st;
};

__device__ __forceinline__ XcdBarrier xcd_barrier_post(unsigned* bar, volatile LAS unsigned* st) {
    XcdBarrier b; b.bar = bar; b.x = xb_xcc_id(); b.st = st;
    if (threadIdx.x == 0) (void)xb_add(&bar[XB_XCNT(b.x)], 1u);
    return b;
}
__device__ __forceinline__ void xcd_barrier_complete(unsigned* bar, unsigned x, unsigned& nloc, unsigned& nx) {
    const unsigned G = gridDim.x * gridDim.y * gridDim.z;
    unsigned sum, cnt, mine, sp = 0u;
    for (;;) {
        sum = 0u; cnt = 0u; mine = 0u;
#pragma unroll
        for (unsigned j = 0; j < 16; ++j) { const unsigned c = xb_ld(&bar[XB_XCNT(j)]); sum += c; cnt += (c > 0u) ? 1u : 0u; mine = (j == x) ? c : mine; }
        if (sum == G) break;
        __builtin_amdgcn_s_sleep(1);
        if ((++sp & 255u) == 0u) { if (xb_ld(&bar[XB_TMO])) break; if (sp > XB_SPIN_CAP) { atomicAdd(&bar[XB_TMO], 1u); break; } }
    }
    nloc = mine > 0u ? mine : 1u; nx = cnt > 0u ? cnt : 1u;
}

__device__ __forceinline__ void xcd_barrier(const XcdBarrier& b) {
    asm volatile("s_waitcnt vmcnt(0)" ::: "memory");
    __syncthreads();
    if (threadIdx.x == 0) {
        unsigned* bar = b.bar;
        __builtin_amdgcn_s_waitcnt(0);
        unsigned nloc = b.st[0], nx = b.st[1];
        if (nloc == 0u) { xcd_barrier_complete(bar, b.x, nloc, nx); b.st[0] = nloc; b.st[1] = nx; }
        const unsigned old = xb_add(&bar[XB_XSUB(b.x)], 1u);
        const unsigned gen = old / nloc;
        if (old + 1u == (gen + 1u) * nloc) {
            __builtin_amdgcn_fence(__ATOMIC_RELEASE, "agent");
            asm volatile("s_waitcnt vmcnt(0)" ::: "memory");
            const unsigned og = xb_add(&bar[XB_TOP], 1u);
            const unsigned tg = og / nx;
            if (og + 1u == (tg + 1u) * nx) xb_add(&bar[XB_TOPGEN], 1u);
            else XB_SPIN(xb_ld(&bar[XB_TOPGEN]) == tg, bar);
            __builtin_amdgcn_fence(__ATOMIC_ACQUIRE, "agent");
            xb_add(&bar[XB_XGEN(b.x)], 1u);
            asm volatile("s_waitcnt vmcnt(0)" ::: "memory");
        } else {
            XB_SPIN(xb_ld(&bar[XB_XGEN(b.x)]) == gen, bar);
            __builtin_amdgcn_fence(__ATOMIC_ACQUIRE, "agent");
            asm volatile("s_waitcnt vmcnt(0)" ::: "memory");
        }
    }
    __syncthreads();
}

__global__ void __launch_bounds__(NTHR, 2) fwd_megakernel(Args a) {
    extern __shared__ __attribute__((aligned(16))) unsigned char lds_raw[];
    LAS unsigned char* lds = (LAS unsigned char*)lds_raw;
    cg::grid_group grid = cg::this_grid();
    const int tid = threadIdx.x, G_ = gridDim.x;
    const int lo = a.ph_lo, hi = a.ph_hi;
    unsigned char* ws = a.ws;
#define IN(k) (lo <= (k) && (k) < hi)
#define SEAM(k) do { if (IN(k) && IN((k) + 1)) { for (int rs_ = 0; rs_ < REP_SYNC; ++rs_) { if ((k) == 0) grid.sync(); else xcd_barrier(bar); } } } while (0)
    volatile LAS unsigned* bst = (volatile LAS unsigned*)(lds + 131072 + 256);
    if (tid < 4) bst[tid] = 0u;
    __syncthreads();
    XcdBarrier bar = xcd_barrier_post((unsigned*)(ws + WS_BAR), bst);
    float* rowss = (float*)(ws + WS_SS);
    bf16* XB = (bf16*)(ws + WS_XB); bf16* HB = (bf16*)(ws + WS_H);
    bf16* Ub = (bf16*)(ws + WS_U); bf16* Vb = (bf16*)(ws + WS_V); bf16* Qb = (bf16*)(ws + WS_Q); float* LFb = (float*)(ws + WS_LF); bf16* Ib = (bf16*)(ws + WS_I); bf16* Gb = (bf16*)(ws + WS_G);
    bf16* Yb = (bf16*)(ws + WS_Y); float* SLOC = (float*)(ws + WS_SLOC); float* DTOT = (float*)(ws + WS_DTOT);

#ifndef SKIP_P0
    if (IN(0)) { for (int rp_ = 0; rp_ < REP_P0; ++rp_) { p0_prologue(a, lds, tid); __syncthreads(); } }
#endif
    SEAM(0);
    for (int l = 0; l < 2; ++l) {
        const int p = 1 + 6 * l;
        unsigned char* wl = ws + WS_W + (size_t)l * W_LAYER;
#ifndef SKIP_G1
        if (IN(p)) for (int rg_ = 0; rg_ < REP_G13; ++rg_) {
            pg8::Gemm g{XB, (const bf16*)(wl + W_IN), M, DIN, D}; pg8::StaticOrder S; S.init(M, DIN, G_, (int)blockIdx.x);
            pg8::EpiIn E{rowss + (size_t)(2 * l) * M, (const float*)(ws + WS_LB) + l * 512, Ub, Vb, Qb, LFb, Ib, Gb};
            pg8::gemm_phase<pg8::EpiIn, pg8::StaticOrder, true, true>(lds, g, S, E);
        }
#endif
        SEAM(p);
#ifndef SKIP_MIX1
        if (IN(p + 1)) for (int rm_ = 0; rm_ < REP_MIX; ++rm_) {
            for (int it = blockIdx.x; it < 256; it += G_)
                hgrn_item<false>(lds, it, Qb, LFb, Ib, Gb, a.in[8] + l * 512, SLOC, DTOT, Yb, tid);
            for (int it = blockIdx.x; it < 512; it += G_)
                gmlp_item(lds, it, Ub, Vb, a.in[3] + (size_t)l * 4 * 128 * 128, a.in[4] + l * 512, a.in[5] + l * 512, a.in[6] + l * 512, Yb, tid);
            __syncthreads();
        }
#endif
        SEAM(p + 1);
#ifndef SKIP_MIX2
        if (IN(p + 2)) for (int rm_ = 0; rm_ < REP_MIX; ++rm_) {
            for (int it = blockIdx.x; it < 256; it += G_)
                hgrn_item<true>(lds, it, Qb, LFb, Ib, Gb, a.in[8] + l * 512, SLOC, DTOT, Yb, tid);
            __syncthreads();
        }
#endif
        SEAM(p + 2);
#ifndef SKIP_G2
        if (IN(p + 3)) {
            pg8::Gemm g{Yb, (const bf16*)(wl + W_OUT), M, D, D}; pg8::StaticOrder S; S.init(M, D, G_, (int)blockIdx.x);
            pg8::EpiRes E{l == 0 ? a.in[0] : a.out, a.out, XB, rowss + (size_t)(2 * l + 1) * M};
            pg8::gemm_phase<pg8::EpiRes, pg8::StaticOrder, false, true>(lds, g, S, E);
        }
#endif
        SEAM(p + 3);
#ifndef SKIP_G3
        if (IN(p + 4)) for (int rg_ = 0; rg_ < REP_G13; ++rg_) {
            pg8::Gemm g{XB, (const bf16*)(wl + W_UP), M, DFF, D}; pg8::StaticOrder S; S.init(M, DFF, G_, (int)blockIdx.x);
            pg8::EpiSq E{rowss + (size_t)(2 * l + 1) * M, HB, DFF};
            pg8::gemm_phase<pg8::EpiSq, pg8::StaticOrder, true, true>(lds, g, S, E);
        }
#endif
        SEAM(p + 4);
#ifndef SKIP_G4
        if (IN(p + 5)) {
            pg8::Gemm g{HB, (const bf16*)(wl + W_DOWN), M, D, DFF}; pg8::StaticOrder S; S.init(M, D, G_, (int)blockIdx.x);
            pg8::EpiRes E{a.out, a.out, XB, rowss + (size_t)(2 * l + 2) * M};
            pg8::gemm_phase<pg8::EpiRes, pg8::StaticOrder, false, true>(lds, g, S, E);
        }
#endif
        SEAM(p + 5);
    }
    if (IN(13)) {
        const int lane = tid & 63, wave = tid >> 6; const float* ssf = rowss + (size_t)4 * M; const f32x4* nf = (const f32x4*)a.in[13] + lane;
        for (int m = blockIdx.x * NWAVES + wave; m < M; m += G_ * NWAVES) {
            const float rs = rsqrtf(ssf[m] * (1.0f / 1024.0f) + EPS);
            f32x4* xr = (f32x4*)(a.out + (size_t)m * D) + lane;
#pragma unroll
            for (int j = 0; j < 4; ++j) { const f32x4 v = xr[64 * j]; xr[64 * j] = v * rs * nf[64 * j]; }
        }
    }
#undef IN
#undef SEAM
}

extern "C" void kernel_launch(void* const* d_in, const int* in_sizes, int n_in, void* d_out, int out_size, void* d_ws, size_t ws_size, hipStream_t stream) {
    static int grid = 0;
    if (grid == 0) {
        if (n_in != 14 || in_sizes[0] != M * D || out_size != M * D || ws_size < WS_END) { fprintf(stderr, "kernel_launch: unexpected shapes (n_in %d, in0 %d, out %d, ws %zu)\n", n_in, n_in > 0 ? in_sizes[0] : -1, out_size, ws_size); grid = -1; return; }
        int dev = 0, cus = 0, per_cu = 0;
        if (hipGetDevice(&dev) != hipSuccess || hipDeviceGetAttribute(&cus, hipDeviceAttributeMultiprocessorCount, dev) != hipSuccess) { grid = -1; return; }
        if (hipFuncSetAttribute((const void*)fwd_megakernel, hipFuncAttributeMaxDynamicSharedMemorySize, LDS_BYTES) != hipSuccess) { fprintf(stderr, "kernel_launch: hipFuncSetAttribute failed\n"); grid = -1; return; }
        if (hipOccupancyMaxActiveBlocksPerMultiprocessor(&per_cu, (const void*)fwd_megakernel, NTHR, LDS_BYTES) != hipSuccess || per_cu < 1) { fprintf(stderr, "kernel_launch: occupancy query reports %d blocks per CU\n", per_cu); (void)hipGetLastError(); grid = -1; return; }
        grid = cus;
    }
    if (grid < 0) return;
    (void)hipMemsetAsync((char*)d_ws + WS_SS, 0, CTL_ZERO_BYTES, stream);
    Args a{};
    for (int i = 0; i < 14; ++i) a.in[i] = (const float*)d_in[i];
    a.out = (float*)d_out; a.ws = (unsigned char*)d_ws;
#if MK_N_LAUNCHES == 1
    a.ph_lo = 0; a.ph_hi = NPHASE;
    void* args[] = {&a};
    hipError_t e = hipLaunchCooperativeKernel((const void*)fwd_megakernel, dim3(grid), dim3(NTHR), args, LDS_BYTES, stream);
    if (e != hipSuccess) fprintf(stderr, "kernel_launch: cooperative launch failed: %s (grid %d)\n", hipGetErrorString(e), grid);
#else
    for (int ph = 0; ph < NPHASE; ++ph) { a.ph_lo = ph; a.ph_hi = ph + 1; hipLaunchKernelGGL(fwd_megakernel, dim3(grid), dim3(NTHR), LDS_BYTES, stream, a); }
#endif
}
```

```cpp
#include <hip/hip_runtime.h>
#include <hip/hip_cooperative_groups.h>
#include <cstdio>
#include <cstdint>
namespace cg = cooperative_groups;
namespace pg8 {
#define PG8_LAS __attribute__((address_space(3)))
typedef unsigned short bf16_t;
typedef short bf16x8 __attribute__((ext_vector_type(8)));
typedef float f32x4 __attribute__((ext_vector_type(4)));
typedef unsigned u32x4 __attribute__((ext_vector_type(4)));
constexpr int BM = 256, BK = 64, HALF = 128, HTB = HALF * BK * 2  , STAGE_BYTES = 8 * HTB, NXCD = 8, WGM = 8;

__host__ __device__ __forceinline__ int lds_byte(int r, int c) { const int st = (r >> 4) * 2 + (c >> 5), rr = r & 15, cc = c & 31, ob = rr * 64 + cc * 2; return st * 1024 + (ob ^ (((ob >> 9) & 1) << 5)); }
__host__ __device__ __forceinline__ void stage_rc(int b, int& R, int& C) { const int st = b / 1024, sb = b % 1024, swz = sb ^ (((sb >> 9) & 1) << 5); R = (st >> 1) * 16 + swz / 64; C = (st & 1) * 32 + (swz % 64) / 2; }
__host__ __device__ __forceinline__ int perm32(int rho) { const int n = rho >> 4, i = rho & 15; return 8 * (i >> 2) + 4 * n + (i & 3); }

struct Unit { int pm, pn; };
struct Gemm { const bf16_t* A; const bf16_t* Bt; int M, N, K; };

struct StaticOrder {
    int nM, nN, nwg, G, c;
    __host__ __device__ void init(int M, int N, int G_, int c_) { nM = M / BM; nN = N / BM; nwg = nM * nN; G = G_; c = c_; }
    __host__ __device__ bool next(int i, Unit& u) const {
        const long L = (long)i * G + c; if (L >= nwg) return false;
        int wgid = (int)L; { const int q = nwg / NXCD, r = nwg % NXCD, xcd = wgid % NXCD, off = wgid / NXCD; wgid = (xcd < r ? xcd * (q + 1) : r * (q + 1) + (xcd - r) * q) + off; }
        const int nig = WGM * nN, gid = wgid / nig, fm = gid * WGM, gsz = (nM - fm) < WGM ? (nM - fm) : WGM;
        u.pm = fm + ((wgid % nig) % gsz); u.pn = (wgid % nig) / gsz; return true;
    }
    __device__ __forceinline__ void a_ready(const Unit&) const {}
    __device__ __forceinline__ void done(const Unit&) const {}
};


__device__ __forceinline__ unsigned cvt_pk_bf16(float lo, float hi) { unsigned r; asm volatile("v_cvt_pk_bf16_f32 %0, %1, %2" : "=v"(r) : "v"(lo), "v"(hi)); return r; }
__device__ __forceinline__ float sigmoidf_fast(float z) { return __builtin_amdgcn_rcpf(1.0f + __expf(-z)); }
__device__ __forceinline__ float gelu_tanh(float x) { const float t = 1.5957691216057308f * (x + 0.044715f * x * x * x); return x * sigmoidf_fast(t); }

struct EpiIn {
    static constexpr bool PERM = true, AFTER_DRAIN = false;
    const float* rowss; const float* lb; bf16_t* U; bf16_t* V; bf16_t* Q; float* LF; bf16_t* I; bf16_t* G;
    __device__ __forceinline__ void operator()(const f32x4 (&acc)[2][2][4][2], const Unit& u, int wr, int wc, int fr, int fq) const {
        const int type = u.pn >> 1;
        const int row0 = u.pm * BM + wr * 64 + fr, cs = (u.pn & 1) * 256 + wc * 32 + 8 * fq;
        if (type == 3) {
            f32x4 l0[2], l1[2];
#pragma unroll
            for (int bj = 0; bj < 2; ++bj) { l0[bj] = *(const f32x4*)(lb + cs + bj * HALF); l1[bj] = *(const f32x4*)(lb + cs + bj * HALF + 4); }
#pragma unroll
            for (int ai = 0; ai < 2; ++ai)
#pragma unroll
                for (int m = 0; m < 4; ++m) { const int row = row0 + ai * HALF + m * 16; const float r = rsqrtf(rowss[row] * (1.0f / 1024.0f) + 1e-6f);
#pragma unroll
                    for (int bj = 0; bj < 2; ++bj) { f32x4 v0 = acc[ai][bj][m][0] * r, v1 = acc[ai][bj][m][1] * r;
#pragma unroll
                        for (int j = 0; j < 4; ++j) { v0[j] = __logf(l0[bj][j] + (1.0f - l0[bj][j]) * sigmoidf_fast(v0[j])); v1[j] = __logf(l1[bj][j] + (1.0f - l1[bj][j]) * sigmoidf_fast(v1[j])); }
                        float* p = LF + (size_t)row * 512 + cs + bj * HALF; *(f32x4*)p = v0; *(f32x4*)(p + 4) = v1; } }
        } else {
            bf16_t* ob = type == 0 ? U : type == 1 ? V : type == 2 ? Q : type == 4 ? I : G;
#pragma unroll
            for (int ai = 0; ai < 2; ++ai)
#pragma unroll
                for (int m = 0; m < 4; ++m) { const int row = row0 + ai * HALF + m * 16; const float r = rsqrtf(rowss[row] * (1.0f / 1024.0f) + 1e-6f);
#pragma unroll
                    for (int bj = 0; bj < 2; ++bj) { f32x4 v0 = acc[ai][bj][m][0] * r, v1 = acc[ai][bj][m][1] * r;
                        if (type <= 1) {
#pragma unroll
                            for (int j = 0; j < 4; ++j) { v0[j] = gelu_tanh(v0[j]); v1[j] = gelu_tanh(v1[j]); } }
                        else if (type == 5) {
#pragma unroll
                            for (int j = 0; j < 4; ++j) { v0[j] = v0[j] * sigmoidf_fast(v0[j]); v1[j] = v1[j] * sigmoidf_fast(v1[j]); } }
                        u32x4 w; w.x = cvt_pk_bf16(v0[0], v0[1]); w.y = cvt_pk_bf16(v0[2], v0[3]); w.z = cvt_pk_bf16(v1[0], v1[1]); w.w = cvt_pk_bf16(v1[2], v1[3]);
                        *(u32x4*)(ob + (size_t)row * 512 + cs + bj * HALF) = w; } }
        }
    }
};
struct EpiSq {
    static constexpr bool PERM = true, AFTER_DRAIN = false;
    const float* rowss; bf16_t* O; int ldc;
    __device__ __forceinline__ void operator()(const f32x4 (&acc)[2][2][4][2], const Unit& u, int wr, int wc, int fr, int fq) const {
        const int row0 = u.pm * BM + wr * 64 + fr, col0 = u.pn * BM + wc * 32 + 8 * fq;
#pragma unroll
        for (int ai = 0; ai < 2; ++ai)
#pragma unroll
            for (int m = 0; m < 4; ++m) { const int row = row0 + ai * HALF + m * 16; const float r = rsqrtf(rowss[row] * (1.0f / 1024.0f) + 1e-6f);
#pragma unroll
                for (int bj = 0; bj < 2; ++bj) { f32x4 v0 = acc[ai][bj][m][0] * r, v1 = acc[ai][bj][m][1] * r;
#pragma unroll
                    for (int j = 0; j < 4; ++j) { const float a = fmaxf(v0[j], 0.f), b = fmaxf(v1[j], 0.f); v0[j] = a * a; v1[j] = b * b; }
                    u32x4 w; w.x = cvt_pk_bf16(v0[0], v0[1]); w.y = cvt_pk_bf16(v0[2], v0[3]); w.z = cvt_pk_bf16(v1[0], v1[1]); w.w = cvt_pk_bf16(v1[2], v1[3]);
                    *(u32x4*)(O + (size_t)row * ldc + col0 + bj * HALF) = w; } }
    }
};
struct EpiRes {
    static constexpr bool PERM = true, AFTER_DRAIN = false;
    const float* xin; float* xout; bf16_t* xb; float* ss_out;
    __device__ __forceinline__ void operator()(const f32x4 (&acc)[2][2][4][2], const Unit& u, int wr, int wc, int fr, int fq) const {
        const int row0 = u.pm * BM + wr * 64 + fr, col0 = u.pn * BM + wc * 32 + 8 * fq;
#pragma unroll
        for (int ai = 0; ai < 2; ++ai)
#pragma unroll
            for (int m = 0; m < 4; ++m) { const int row = row0 + ai * HALF + m * 16; float ss = 0.f;
#pragma unroll
                for (int bj = 0; bj < 2; ++bj) { const size_t off = (size_t)row * 1024 + col0 + bj * HALF;
                    const f32x4 a0 = *(const f32x4*)(xin + off), a1 = *(const f32x4*)(xin + off + 4);
                    const f32x4 o0 = a0 + acc[ai][bj][m][0], o1 = a1 + acc[ai][bj][m][1];
                    *(f32x4*)(xout + off) = o0; *(f32x4*)(xout + off + 4) = o1;
                    u32x4 w; w.x = cvt_pk_bf16(o0[0], o0[1]); w.y = cvt_pk_bf16(o0[2], o0[3]); w.z = cvt_pk_bf16(o1[0], o1[1]); w.w = cvt_pk_bf16(o1[2], o1[3]);
                    *(u32x4*)(xb + off) = w;
                    ss += (o0[0] * o0[0] + o0[1] * o0[1]) + (o0[2] * o0[2] + o0[3] * o0[3]) + (o1[0] * o1[0] + o1[1] * o1[1]) + (o1[2] * o1[2] + o1[3] * o1[3]); }
                ss += __shfl_xor(ss, 16); ss += __shfl_xor(ss, 32);
                if (fq == 0) atomicAdd(ss_out + row, ss); }
    }
};

template <class Epi, class Sched, bool ALIGN_EPI = false, bool SP2 = false>
__device__ __forceinline__ void gemm_phase(PG8_LAS unsigned char* lds, const Gemm g, const Sched& S, const Epi& E) {
    int tid_ = threadIdx.x; asm volatile("" : "+v"(tid_));
    const int tid = tid_, wid = __builtin_amdgcn_readfirstlane(tid >> 6), lane = tid & 63, wr = wid >> 2, wc = wid & 3, fr = lane & 15, fq = lane >> 4;
    const int K = g.K, nt = K / BK;
    unsigned voffA[2], voffB[2];
#pragma unroll
    for (int i = 0; i < 2; ++i) { int R, C; stage_rc(tid * 16 + i * 8192, R, C); const int Rb = Epi::PERM ? ((R & ~31) + perm32(R & 31)) : R;
        voffA[i] = (unsigned)(R * K + C) * 2u; voffB[i] = (unsigned)(Rb * K + C) * 2u; }
    const size_t kstep = (size_t)(BK * 2);
    const size_t hstep = (size_t)HALF * K * 2;
    const size_t tstep = 2 * hstep;
    const unsigned ldsw = (unsigned)wid * 1024u;
    const int aoff = lds_byte(wr * 64 + fr, fq * 8), boff = lds_byte(wc * 32 + fr, fq * 8);
#define PG8_SA(b, h) (((b) * 2 + (h)) * HTB)
#define PG8_SB(b, h) ((4 + (b) * 2 + (h)) * HTB)
#define PG8_STAGE(bufoff, gbase, voff) do { _Pragma("unroll") for (int _i = 0; _i < 2; ++_i) \
        __builtin_amdgcn_global_load_lds((const unsigned*)((const char*)(gbase) + (voff)[_i]), (PG8_LAS unsigned*)(lds + (bufoff) + ldsw + _i * 8192), 16, 0, 0); } while (0)
#define PG8_LDA(dst, b, h) do { _Pragma("unroll") for (int m = 0; m < 4; ++m) _Pragma("unroll") for (int k = 0; k < 2; ++k) dst[m][k] = *(const PG8_LAS bf16x8*)(lds + PG8_SA(b, h) + aoff + m * 2048 + k * 1024); } while (0)
#define PG8_LDB(dst, b, h) do { _Pragma("unroll") for (int n = 0; n < 2; ++n) _Pragma("unroll") for (int k = 0; k < 2; ++k) dst[n][k] = *(const PG8_LAS bf16x8*)(lds + PG8_SB(b, h) + boff + n * 2048 + k * 1024); } while (0)
#define PG8_MMA(ai, bj, At, Bt) do { __builtin_amdgcn_s_setprio(1); _Pragma("unroll") for (int m = 0; m < 4; ++m) _Pragma("unroll") for (int n = 0; n < 2; ++n) _Pragma("unroll") for (int k = 0; k < 2; ++k) \
        acc[ai][bj][m][n] = __builtin_amdgcn_mfma_f32_16x16x32_bf16(Bt[n][k], At[m][k], acc[ai][bj][m][n], 0, 0, 0); __builtin_amdgcn_s_setprio(0); } while (0)
#define PG8_WAIT_V(n) asm volatile("s_waitcnt vmcnt(" #n ")" ::: "memory")
#define PG8_WAIT_L(n) asm volatile("s_waitcnt lgkmcnt(" #n ")" ::: "memory")
#define PG8_BAR __builtin_amdgcn_s_barrier()
#define PG8_SCHED __builtin_amdgcn_sched_barrier(0)
    Unit cur, nxt; int ui = 0;
    if (!S.next(0, cur)) return;
    f32x4 acc[2][2][4][2];
#pragma unroll
    for (int a = 0; a < 2; ++a)
#pragma unroll
        for (int b = 0; b < 2; ++b)
#pragma unroll
            for (int m = 0; m < 4; ++m)
#pragma unroll
                for (int n = 0; n < 2; ++n) acc[a][b][m][n] = (f32x4){0.f, 0.f, 0.f, 0.f};
    bf16x8 At[4][2], B0[2][2], B1[2][2];
    const char* cA = (const char*)g.A + (size_t)cur.pm * tstep; const char* cB = (const char*)g.Bt + (size_t)cur.pn * tstep;
    S.a_ready(cur);
    if constexpr (SP2) {
        PG8_STAGE(PG8_SB(0, 0), cB, voffB); PG8_STAGE(PG8_SB(0, 1), cB + hstep, voffB); PG8_STAGE(PG8_SA(0, 0), cA, voffA); PG8_STAGE(PG8_SA(0, 1), cA + hstep, voffA);
        if (wr == 1) PG8_BAR;
        PG8_WAIT_V(2); PG8_BAR;
        PG8_STAGE(PG8_SB(1, 0), cB + kstep, voffB); PG8_STAGE(PG8_SA(1, 0), cA + kstep, voffA); PG8_STAGE(PG8_SB(1, 1), cB + hstep + kstep, voffB);
        PG8_WAIT_V(6); PG8_BAR;
    } else {
        PG8_STAGE(PG8_SB(0, 0), cB, voffB); PG8_STAGE(PG8_SA(0, 0), cA, voffA); PG8_STAGE(PG8_SB(0, 1), cB + hstep, voffB); PG8_STAGE(PG8_SA(0, 1), cA + hstep, voffA);
        if (wr == 1) PG8_BAR;
        PG8_WAIT_V(4); PG8_BAR;
        PG8_STAGE(PG8_SB(1, 0), cB + kstep, voffB); PG8_STAGE(PG8_SA(1, 0), cA + kstep, voffA); PG8_STAGE(PG8_SB(1, 1), cB + hstep + kstep, voffB);
        PG8_WAIT_V(6); PG8_BAR;
    }
    for (;;) {
        const bool has_next = S.next(ui + 1, nxt);
        const char* nA = has_next ? (const char*)g.A + (size_t)nxt.pm * tstep : cA; const char* nB = has_next ? (const char*)g.Bt + (size_t)nxt.pn * tstep : cB;
        for (int t = 0; t < nt; t += 2) {
            const bool last = (t == nt - 2);
            const char* a1 = cA + (size_t)(t + 1) * kstep;
            const char* a2 = last ? nA : cA + (size_t)(t + 2) * kstep; const char* b2 = last ? nB : cB + (size_t)(t + 2) * kstep;
            const char* a3 = a2 + kstep; const char* b3 = b2 + kstep;
            if (last && has_next) S.a_ready(nxt);
            if constexpr (SP2) {
            PG8_LDB(B0, 0, 0); PG8_LDB(B1, 0, 1); PG8_SCHED; PG8_LDA(At, 0, 0); PG8_STAGE(PG8_SA(1, 1), a1 + hstep, voffA);
            PG8_WAIT_V(8); PG8_WAIT_L(0); PG8_BAR; PG8_MMA(0, 0, At, B0); PG8_MMA(0, 1, At, B1); PG8_BAR; PG8_SCHED;
            PG8_LDA(At, 0, 1); PG8_STAGE(PG8_SB(0, 0), b2, voffB); PG8_STAGE(PG8_SB(0, 1), b2 + hstep, voffB); PG8_STAGE(PG8_SA(0, 0), a2, voffA);
            PG8_WAIT_V(8); PG8_WAIT_L(0); PG8_BAR; PG8_MMA(1, 0, At, B0); PG8_MMA(1, 1, At, B1); PG8_BAR; PG8_SCHED;
            PG8_LDB(B0, 1, 0); PG8_LDB(B1, 1, 1); PG8_SCHED; PG8_LDA(At, 1, 0); PG8_STAGE(PG8_SA(0, 1), a2 + hstep, voffA);
            PG8_WAIT_V(8); PG8_WAIT_L(0); PG8_BAR; PG8_MMA(0, 0, At, B0); PG8_MMA(0, 1, At, B1); PG8_BAR; PG8_SCHED;
            PG8_LDA(At, 1, 1); PG8_STAGE(PG8_SB(1, 0), b3, voffB); PG8_STAGE(PG8_SB(1, 1), b3 + hstep, voffB); PG8_STAGE(PG8_SA(1, 0), a3, voffA);
            PG8_WAIT_V(8); PG8_WAIT_L(0); PG8_BAR; PG8_MMA(1, 0, At, B0); PG8_MMA(1, 1, At, B1); PG8_BAR; PG8_SCHED;
            } else {
            PG8_LDB(B0, 0, 0); PG8_SCHED; PG8_LDA(At, 0, 0); PG8_STAGE(PG8_SA(1, 1), a1 + hstep, voffA);
            PG8_WAIT_L(8); PG8_BAR; PG8_WAIT_L(0); PG8_MMA(0, 0, At, B0); PG8_BAR; PG8_SCHED;
            PG8_LDB(B1, 0, 1); PG8_STAGE(PG8_SB(0, 0), b2, voffB);
            PG8_BAR; PG8_WAIT_L(0); PG8_MMA(0, 1, At, B1); PG8_BAR;
            PG8_LDA(At, 0, 1); PG8_STAGE(PG8_SA(0, 0), a2, voffA);
            PG8_BAR; PG8_WAIT_L(0); PG8_MMA(1, 0, At, B0); PG8_BAR; PG8_SCHED;
            PG8_STAGE(PG8_SB(0, 1), b2 + hstep, voffB);
            PG8_WAIT_V(6); PG8_BAR; PG8_MMA(1, 1, At, B1); PG8_BAR;
            PG8_LDB(B0, 1, 0); PG8_SCHED; PG8_LDA(At, 1, 0); PG8_STAGE(PG8_SA(0, 1), a2 + hstep, voffA);
            PG8_WAIT_L(8); PG8_BAR; PG8_WAIT_L(0); PG8_MMA(0, 0, At, B0); PG8_BAR; PG8_SCHED;
            PG8_LDB(B1, 1, 1); PG8_STAGE(PG8_SB(1, 0), b3, voffB);
            PG8_BAR; PG8_WAIT_L(0); PG8_MMA(0, 1, At, B1); PG8_BAR;
            PG8_LDA(At, 1, 1); PG8_STAGE(PG8_SA(1, 0), a3, voffA);
            PG8_BAR; PG8_WAIT_L(0); PG8_MMA(1, 0, At, B0); PG8_BAR; PG8_SCHED;
            PG8_STAGE(PG8_SB(1, 1), b3 + hstep, voffB);
            PG8_WAIT_V(6); PG8_BAR; PG8_MMA(1, 1, At, B1); PG8_BAR;
            }
        }
        if constexpr (ALIGN_EPI) { if (wr == 0) PG8_BAR; }
        if constexpr (!Epi::AFTER_DRAIN) { E(acc, cur, wr, wc, fr, fq); S.done(cur); }
        if (!has_next) break;
#pragma unroll
        for (int a = 0; a < 2; ++a)
#pragma unroll
            for (int b = 0; b < 2; ++b)
#pragma unroll
                for (int m = 0; m < 4; ++m)
#pragma unroll
                    for (int n = 0; n < 2; ++n) acc[a][b][m][n] = (f32x4){0.f, 0.f, 0.f, 0.f};
        cur = nxt; cA = nA; cB = nB; ++ui;
        if constexpr (ALIGN_EPI) { if (wr == 1) PG8_BAR; }
    }
    PG8_WAIT_V(0);
    if constexpr (!ALIGN_EPI) { if (wr == 0) PG8_BAR; }
    PG8_BAR;
    if constexpr (Epi::AFTER_DRAIN) { E.fused(acc, cur, wr, wc, fr, fq, lds, wid, lane); S.done(cur); }
#undef PG8_SA
#undef PG8_SB
#undef PG8_STAGE
#undef PG8_LDA
#undef PG8_LDB
#undef PG8_MMA
#undef PG8_WAIT_V
#undef PG8_WAIT_L
#undef PG8_BAR
#undef PG8_SCHED
}
}

#ifndef MK_N_LAUNCHES
#define MK_N_LAUNCHES 1
#endif
#ifndef REP_MIX
#define REP_MIX 1
#endif
#ifndef REP_G13
#define REP_G13 1
#endif
#ifndef REP_SYNC
#define REP_SYNC 1
#endif
#ifndef REP_P0
#define REP_P0 1
#endif
constexpr int NWAVES = 8, NTHR = 512;
constexpr int M = 16384, D = 1024, DIN = 3072, DFF = 4096, SEQ = 4096;
constexpr int NPHASE = 14;
constexpr float EPS = 1e-6f;
constexpr size_t MiB = 1u << 20;
constexpr size_t WS_SS = 0, SS_BYTES = 5 * (size_t)M * 4;
constexpr size_t WS_BAR = 384 * 1024;
constexpr size_t CTL_ZERO_BYTES = 448 * 1024;
constexpr size_t WS_LB = 512 * 1024;
constexpr size_t WS_W = 1 * MiB, W_LAYER = 24 * MiB, W_IN = 0, W_OUT = 6 * MiB, W_UP = 8 * MiB, W_DOWN = 16 * MiB;
constexpr size_t WS_XB = 49 * MiB;
constexpr size_t WS_H = 81 * MiB;
constexpr size_t WS_U = 81 * MiB, WS_V = 97 * MiB, WS_Q = 113 * MiB, WS_LF = 129 * MiB, WS_I = 161 * MiB, WS_G = 177 * MiB, WS_Y = 193 * MiB, WS_SLOC = 225 * MiB, WS_DTOT = 241 * MiB;
constexpr size_t WS_END = 242 * MiB;
constexpr int LDS_BYTES = 147456;

#define LAS __attribute__((address_space(3)))
typedef unsigned short bf16;
typedef unsigned v4u __attribute__((ext_vector_type(4)));
typedef unsigned v2u __attribute__((ext_vector_type(2)));
typedef float f32x4 __attribute__((ext_vector_type(4)));
typedef float f32x16 __attribute__((ext_vector_type(16)));
typedef short bf16x8 __attribute__((ext_vector_type(8)));
#define LDS_WAIT() asm volatile("s_waitcnt lgkmcnt(0)" ::: "memory")
__device__ __forceinline__ unsigned pkbf(float lo, float hi) { return pg8::cvt_pk_bf16(lo, hi); }
__device__ __forceinline__ float bf_lo(unsigned w) { return __uint_as_float(w << 16); }
__device__ __forceinline__ float bf_hi(unsigned w) { return __uint_as_float(w & 0xffff0000u); }
__device__ __forceinline__ float bf1(bf16 v) { return __uint_as_float(((unsigned)v) << 16); }
__device__ __forceinline__ bf16 tobf(float f) { return (bf16)(pg8::cvt_pk_bf16(f, 0.f) & 0xffffu); }
__device__ __forceinline__ float wave_sum(float v) {
#pragma unroll
    for (int o = 1; o < 64; o <<= 1) v += __shfl_xor(v, o);
    return v;
}

__device__ __forceinline__ void p0_transpose_item(const float* W, int K, int N, bf16* WT, const float* ksc, LAS float* scr, int item, int lane) {
    const int nblk = N / 32, kb = item / nblk, nb = item % nblk, k0 = 64 * kb, n0 = 32 * nb;
    const int kr = lane >> 3, n4 = (lane & 7) * 4;
    f32x4 v[8];
#pragma unroll
    for (int i = 0; i < 8; ++i) v[i] = *(const f32x4*)(W + (size_t)(k0 + 8 * i + kr) * N + n0 + n4);
#pragma unroll
    for (int i = 0; i < 8; ++i) { const int kk = 8 * i + kr; const float s = ksc ? ksc[k0 + kk] : 1.0f; LAS float* d = scr + kk * 33 + n4;
        d[0] = v[i].x * s; d[1] = v[i].y * s; d[2] = v[i].z * s; d[3] = v[i].w * s; }
    LDS_WAIT(); asm volatile("" ::: "memory");
    const int c = lane & 7;
#pragma unroll
    for (int j = 0; j < 4; ++j) { const int n = (lane >> 3) + 8 * j; const LAS float* sp = scr + (8 * c) * 33 + n;
        v4u o; o.x = pkbf(sp[0 * 33], sp[1 * 33]); o.y = pkbf(sp[2 * 33], sp[3 * 33]); o.z = pkbf(sp[4 * 33], sp[5 * 33]); o.w = pkbf(sp[6 * 33], sp[7 * 33]);
        *(v4u*)(WT + (size_t)(n0 + n) * K + k0 + 8 * c) = o; }
    LDS_WAIT(); asm volatile("" ::: "memory");
}

struct Args { const float* in[14]; float* out; unsigned char* ws; int ph_lo, ph_hi; };

__device__ __forceinline__ void p0_prologue(const Args& a, LAS unsigned char* lds, int tid_) {
    int tid = tid_; asm volatile("" : "+v"(tid));
    const int lane = tid & 63, wave = tid >> 6;
    LAS float* scr = (LAS float*)(lds + wave * 16384);
    const int gw = blockIdx.x * NWAVES + wave, NGW = gridDim.x * NWAVES;
    constexpr int I_IN = (D / 64) * (DIN / 32), I_OUT = (D / 64) * (D / 32), I_UP = (D / 64) * (DFF / 32), I_DN = (DFF / 64) * (D / 32), I_L = I_IN + I_OUT + I_UP + I_DN;
    for (int it = gw; it < 2 * I_L; it += NGW) {
        const int l = it / I_L; int r = it % I_L;
        unsigned char* wl = a.ws + WS_W + (size_t)l * W_LAYER;
        if (r < I_IN) { p0_transpose_item(a.in[2] + (size_t)l * D * DIN, D, DIN, (bf16*)(wl + W_IN), a.in[1] + l * D, scr, r, lane); continue; } r -= I_IN;
        if (r < I_OUT) { p0_transpose_item(a.in[9] + (size_t)l * D * D, D, D, (bf16*)(wl + W_OUT), nullptr, scr, r, lane); continue; } r -= I_OUT;
        if (r < I_UP) { p0_transpose_item(a.in[11] + (size_t)l * D * DFF, D, DFF, (bf16*)(wl + W_UP), a.in[10] + l * D, scr, r, lane); continue; } r -= I_UP;
        p0_transpose_item(a.in[12] + (size_t)l * DFF * D, DFF, D, (bf16*)(wl + W_DOWN), nullptr, scr, r, lane);
    }
    bf16* XB = (bf16*)(a.ws + WS_XB); float* ss0 = (float*)(a.ws + WS_SS);
    for (int m = gw; m < M; m += NGW) {
        const f32x4* xr = (const f32x4*)(a.in[0] + (size_t)m * D) + lane; float s = 0.f;
        unsigned long long* o8 = (unsigned long long*)(XB + (size_t)m * D) + lane;
#pragma unroll
        for (int j = 0; j < 4; ++j) { const f32x4 v = xr[64 * j]; s += (v.x * v.x + v.y * v.y) + (v.z * v.z + v.w * v.w);
            o8[64 * j] = (unsigned long long)pkbf(v.x, v.y) | ((unsigned long long)pkbf(v.z, v.w) << 32); }
        s = wave_sum(s);
        if (lane == 0) ss0[m] = s;
    }
    if (blockIdx.x == 0) { float* lbv = (float*)(a.ws + WS_LB); const float* lw = a.in[7];
        for (int c = tid; c < 512; c += NTHR) { const float a0 = lw[c], a1 = lw[512 + c]; lbv[c] = 0.f; lbv[512 + c] = 1.0f / (1.0f + expf(a0 - a1)); } }
}

__device__ __forceinline__ void gmlp_item(LAS unsigned char* lds, int item, const bf16* U, const bf16* V, const float* Wsp, const float* bsp, const float* gv, const float* go, bf16* Y, int tid_) {
    int tid = tid_; asm volatile("" : "+v"(tid));
    const int g = item & 3, row0 = (item >> 2) * 128;
    const int lane = tid & 63, w = tid >> 6, r = lane & 31, hh = lane >> 5;
    LAS unsigned char* VnT = lds; LAS float* red = (LAS float*)(lds + 34816); LAS float* ssqb = (LAS float*)(lds + 38912);
    __syncthreads();
    {
        const int sp = lane, cr = w;
        const bf16* vp = V + (size_t)(row0 + 2 * sp) * 512 + g * 128 + cr * 16;
        const v4u a0 = *(const v4u*)vp, a1 = *(const v4u*)(vp + 8), b0 = *(const v4u*)(vp + 512), b1 = *(const v4u*)(vp + 520);
        float va[16], vb[16];
#pragma unroll
        for (int j = 0; j < 4; ++j) { va[2 * j] = bf_lo(a0[j]); va[2 * j + 1] = bf_hi(a0[j]); va[8 + 2 * j] = bf_lo(a1[j]); va[9 + 2 * j] = bf_hi(a1[j]);
            vb[2 * j] = bf_lo(b0[j]); vb[2 * j + 1] = bf_hi(b0[j]); vb[8 + 2 * j] = bf_lo(b1[j]); vb[9 + 2 * j] = bf_hi(b1[j]); }
        float sa = 0.f, sb = 0.f;
#pragma unroll
        for (int j = 0; j < 16; ++j) { sa += va[j] * va[j]; sb += vb[j] * vb[j]; }
        red[cr * 128 + 2 * sp] = sa; red[cr * 128 + 2 * sp + 1] = sb;
        __syncthreads();
        float ta = 0.f, tb = 0.f;
#pragma unroll
        for (int k = 0; k < 8; ++k) { ta += red[k * 128 + 2 * sp]; tb += red[k * 128 + 2 * sp + 1]; }
        const float ra = rsqrtf(ta * (1.0f / 128.0f) + EPS), rb = rsqrtf(tb * (1.0f / 128.0f) + EPS);
#pragma unroll
        for (int j = 0; j < 16; ++j) { const int c = cr * 16 + j; const float gw = gv[g * 128 + c];
            *(LAS unsigned*)(VnT + c * 272 + sp * 4) = pkbf(va[j] * ra * gw, vb[j] * rb * gw); }
    }
    __syncthreads();
    const int cb = w >> 1;
    f32x16 acc[2]; float yv[2][16];
#pragma unroll
    for (int x = 0; x < 2; ++x) {
        const int tb = (w & 1) ? (x == 0 ? 1 : 2) : (x == 0 ? 0 : 3);
        const int t = tb * 32 + r;
#pragma unroll
        for (int q = 0; q < 16; ++q) acc[x][q] = 0.f;
        const float* wrow = Wsp + (size_t)(g * 128 + t) * 128 + 8 * hh;
        const int nks = (tb + 1) * 2;
        for (int ks = 0; ks < nks; ++ks) {
            const bf16x8 af = *(const LAS bf16x8*)(VnT + (cb * 32 + r) * 272 + (ks * 16 + 8 * hh) * 2);
            const f32x4 w0 = *(const f32x4*)(wrow + ks * 16), w1 = *(const f32x4*)(wrow + ks * 16 + 4);
            const int s0 = ks * 16 + 8 * hh;
            float e[8] = {w0[0], w0[1], w0[2], w0[3], w1[0], w1[1], w1[2], w1[3]};
#pragma unroll
            for (int j = 0; j < 8; ++j) e[j] = (s0 + j <= t) ? e[j] : 0.f;
            v4u bw; bw.x = pkbf(e[0], e[1]); bw.y = pkbf(e[2], e[3]); bw.z = pkbf(e[4], e[5]); bw.w = pkbf(e[6], e[7]);
            acc[x] = __builtin_amdgcn_mfma_f32_32x32x16_bf16(af, __builtin_bit_cast(bf16x8, bw), acc[x], 0, 0, 0);
        }
        const float bias = bsp[g * 128 + t]; float ssq = 0.f;
#pragma unroll
        for (int i = 0; i < 4; ++i) { const int c = cb * 32 + 8 * i + 4 * hh;
            const v2u uw = *(const v2u*)(U + (size_t)(row0 + t) * 512 + g * 128 + c);
            const float u0 = bf_lo(uw.x), u1 = bf_hi(uw.x), u2 = bf_lo(uw.y), u3 = bf_hi(uw.y);
            yv[x][4 * i + 0] = u0 * (acc[x][4 * i + 0] + bias); yv[x][4 * i + 1] = u1 * (acc[x][4 * i + 1] + bias);
            yv[x][4 * i + 2] = u2 * (acc[x][4 * i + 2] + bias); yv[x][4 * i + 3] = u3 * (acc[x][4 * i + 3] + bias);
#pragma unroll
            for (int j = 0; j < 4; ++j) ssq += yv[x][4 * i + j] * yv[x][4 * i + j]; }
        ssq += __shfl_xor(ssq, 32);
        if (hh == 0) ssqb[cb * 128 + t] = ssq;
    }
    __syncthreads();
#pragma unroll
    for (int x = 0; x < 2; ++x) {
        const int tb = (w & 1) ? (x == 0 ? 1 : 2) : (x == 0 ? 0 : 3);
        const int t = tb * 32 + r;
        const float tot = (ssqb[t] + ssqb[128 + t]) + (ssqb[256 + t] + ssqb[384 + t]);
        const float rs = rsqrtf(tot * (1.0f / 128.0f) + EPS);
#pragma unroll
        for (int i = 0; i < 4; ++i) { const int c = cb * 32 + 8 * i + 4 * hh; const f32x4 gw = *(const f32x4*)(go + g * 128 + c);
            v2u o; o.x = pkbf(yv[x][4 * i] * rs * gw[0], yv[x][4 * i + 1] * rs * gw[1]); o.y = pkbf(yv[x][4 * i + 2] * rs * gw[2], yv[x][4 * i + 3] * rs * gw[3]);
            *(v2u*)(Y + (size_t)(row0 + t) * 1024 + g * 128 + c) = o; }
    }
}

template <bool OUT>
__device__ __forceinline__ void hgrn_item(LAS unsigned char* lds, int item, const bf16* Q, const float* LF, const bf16* I, const bf16* G, const float* gbo, float* SLOC, float* DTOT, bf16* Y, int tid_) {
    int tid = tid_; asm volatile("" : "+v"(tid));
    const int sc = item & 15, bh = item >> 4, b = bh >> 2, h = bh & 3;
    const int rowbase = b * SEQ + sc * 256;
    const int lane = tid & 63, w = tid >> 6, r = lane & 31, hh = lane >> 5;
    LAS unsigned char* Q1s = lds; LAS unsigned char* K1s = lds + 17408; LAS unsigned char* K2T = lds + 34816; LAS unsigned char* VT = lds + 53248;
    LAS unsigned char* ST = lds + 71680; LAS unsigned char* Ps = lds + 106496;
    LAS float* totb = (LAS float*)(lds + 115712); LAS float* dl = (LAS float*)(lds + 117760); LAS float* ssqb = (LAS float*)(lds + 118272);
    const int kb = w >> 1, vb0 = (w & 1) * 2;
    const int vb = w >> 1, tb = w & 1;
    f32x16 S[2];
#pragma unroll
    for (int x = 0; x < 2; ++x)
#pragma unroll
        for (int q = 0; q < 16; ++q) S[x][q] = 0.f;
    __syncthreads();
    if (OUT) {
        for (int m = 0; m < sc; ++m) {
            const float* dt = DTOT + (size_t)(bh * 16 + m) * 128; const float* sl = SLOC + (size_t)(bh * 16 + m) * 16384;
#pragma unroll
            for (int i = 0; i < 4; ++i) { const int k0 = kb * 32 + 8 * i + 4 * hh; const f32x4 d4 = *(const f32x4*)(dt + k0);
#pragma unroll
                for (int x = 0; x < 2; ++x)
#pragma unroll
                    for (int j = 0; j < 4; ++j) S[x][4 * i + j] = d4[j] * S[x][4 * i + j] + sl[(size_t)(k0 + j) * 128 + (vb0 + x) * 32 + r]; }
        }
#pragma unroll
        for (int x = 0; x < 2; ++x)
#pragma unroll
            for (int i = 0; i < 4; ++i) { v2u o; o.x = pkbf(S[x][4 * i], S[x][4 * i + 1]); o.y = pkbf(S[x][4 * i + 2], S[x][4 * i + 3]);
                *(LAS v2u*)(ST + ((vb0 + x) * 32 + r) * 272 + (kb * 32 + 8 * i + 4 * hh) * 2) = o; }
    }
    const int ch = tid & 127, part = tid >> 7;
    float btot = 0.f;
    for (int jc = 0; jc < 4; ++jc) {
        const int row0 = rowbase + jc * 64;
        float cs[16]; unsigned short iv[16], qv[16];
        {
            const size_t e0 = (size_t)(row0 + part * 16) * 512 + h * 128 + ch;
#pragma unroll
            for (int i = 0; i < 16; ++i) { cs[i] = LF[e0 + (size_t)i * 512]; iv[i] = I[e0 + (size_t)i * 512]; if (OUT) qv[i] = Q[e0 + (size_t)i * 512]; }
        }
        float lfv[16];
#pragma unroll
        for (int i = 0; i < 16; ++i) lfv[i] = cs[i];
#pragma unroll
        for (int i = 1; i < 16; ++i) cs[i] += cs[i - 1];
        totb[part * 128 + ch] = cs[15];
        __syncthreads();
        const float t0 = totb[ch], t1 = totb[128 + ch], t2 = totb[256 + ch], t3 = totb[384 + ch];
        const float off = (part > 0 ? t0 : 0.f) + (part > 1 ? t1 : 0.f) + (part > 2 ? t2 : 0.f);
        const float bl = (t0 + t1) + (t2 + t3);
        {
            unsigned k2w[8], vw[8];
#pragma unroll
            for (int i = 0; i < 16; i += 2) {
                const float b0 = off + cs[i], b1 = off + cs[i + 1];
                const float k0 = 1.0f - __expf(lfv[i]), k1 = 1.0f - __expf(lfv[i + 1]);
                k2w[i >> 1] = pkbf(k0 * __expf(bl - b0), k1 * __expf(bl - b1));
                vw[i >> 1] = (unsigned)iv[i] | ((unsigned)iv[i + 1] << 16);
                if (OUT) {
                    const float q0 = bf1(qv[i]) * __expf(b0), q1 = bf1(qv[i + 1]) * __expf(b1);
                    const float c0 = k0 * __expf(fminf(-b0, 80.f)), c1 = k1 * __expf(fminf(-b1, 80.f));
                    *(LAS bf16*)(Q1s + (part * 16 + i) * 272 + ch * 2) = tobf(q0); *(LAS bf16*)(Q1s + (part * 16 + i + 1) * 272 + ch * 2) = tobf(q1);
                    *(LAS bf16*)(K1s + (part * 16 + i) * 272 + ch * 2) = tobf(c0); *(LAS bf16*)(K1s + (part * 16 + i + 1) * 272 + ch * 2) = tobf(c1);
                }
            }
            *(LAS v4u*)(K2T + ch * 144 + part * 32) = (v4u){k2w[0], k2w[1], k2w[2], k2w[3]}; *(LAS v4u*)(K2T + ch * 144 + part * 32 + 16) = (v4u){k2w[4], k2w[5], k2w[6], k2w[7]};
            *(LAS v4u*)(VT + ch * 144 + part * 32) = (v4u){vw[0], vw[1], vw[2], vw[3]}; *(LAS v4u*)(VT + ch * 144 + part * 32 + 16) = (v4u){vw[4], vw[5], vw[6], vw[7]};
            if (part == 0) { dl[ch] = __expf(bl); btot += bl; }
        }
        __syncthreads();
        f32x16 accO;
#pragma unroll
        for (int q = 0; q < 16; ++q) accO[q] = 0.f;
        if (OUT) {
            if (w < 3) {
                const int sb = (w == 2) ? 1 : 0, tbs = (w == 0) ? 0 : 1;
                f32x16 sa;
#pragma unroll
                for (int q = 0; q < 16; ++q) sa[q] = 0.f;
#pragma unroll
                for (int ks = 0; ks < 8; ++ks) {
                    const bf16x8 af = *(const LAS bf16x8*)(K1s + (sb * 32 + r) * 272 + (ks * 16 + 8 * hh) * 2);
                    const bf16x8 bfr = *(const LAS bf16x8*)(Q1s + (tbs * 32 + r) * 272 + (ks * 16 + 8 * hh) * 2);
                    sa = __builtin_amdgcn_mfma_f32_32x32x16_bf16(af, bfr, sa, 0, 0, 0);
                }
                const int t = tbs * 32 + r;
#pragma unroll
                for (int i = 0; i < 4; ++i) { const int s0 = sb * 32 + 8 * i + 4 * hh;
                    const float p0 = (s0 + 0 <= t) ? sa[4 * i + 0] : 0.f, p1 = (s0 + 1 <= t) ? sa[4 * i + 1] : 0.f, p2 = (s0 + 2 <= t) ? sa[4 * i + 2] : 0.f, p3 = (s0 + 3 <= t) ? sa[4 * i + 3] : 0.f;
                    v2u o; o.x = pkbf(p0, p1); o.y = pkbf(p2, p3);
                    *(LAS v2u*)(Ps + t * 144 + s0 * 2) = o; }
            }
#pragma unroll
            for (int ks = 0; ks < 8; ++ks) {
                const bf16x8 af = *(const LAS bf16x8*)(ST + (vb * 32 + r) * 272 + (ks * 16 + 8 * hh) * 2);
                const bf16x8 bfr = *(const LAS bf16x8*)(Q1s + (tb * 32 + r) * 272 + (ks * 16 + 8 * hh) * 2);
                accO = __builtin_amdgcn_mfma_f32_32x32x16_bf16(af, bfr, accO, 0, 0, 0);
            }
            __syncthreads();
            const int nks = (tb + 1) * 2;
            for (int ks = 0; ks < nks; ++ks) {
                const bf16x8 af = *(const LAS bf16x8*)(VT + (vb * 32 + r) * 144 + (ks * 16 + 8 * hh) * 2);
                const bf16x8 bfr = *(const LAS bf16x8*)(Ps + (tb * 32 + r) * 144 + (ks * 16 + 8 * hh) * 2);
                accO = __builtin_amdgcn_mfma_f32_32x32x16_bf16(af, bfr, accO, 0, 0, 0);
            }
        }
        if (!OUT || jc < 3) {
#pragma unroll
            for (int i = 0; i < 4; ++i) { const f32x4 d4 = *(const LAS f32x4*)(dl + kb * 32 + 8 * i + 4 * hh);
#pragma unroll
                for (int x = 0; x < 2; ++x)
#pragma unroll
                    for (int j = 0; j < 4; ++j) S[x][4 * i + j] *= d4[j]; }
#pragma unroll
            for (int ks = 0; ks < 4; ++ks) {
                const bf16x8 af = *(const LAS bf16x8*)(K2T + (kb * 32 + r) * 144 + (ks * 16 + 8 * hh) * 2);
#pragma unroll
                for (int x = 0; x < 2; ++x) {
                    const bf16x8 bfr = *(const LAS bf16x8*)(VT + ((vb0 + x) * 32 + r) * 144 + (ks * 16 + 8 * hh) * 2);
                    S[x] = __builtin_amdgcn_mfma_f32_32x32x16_bf16(af, bfr, S[x], 0, 0, 0);
                }
            }
            if (OUT) {
#pragma unroll
                for (int x = 0; x < 2; ++x)
#pragma unroll
                    for (int i = 0; i < 4; ++i) { v2u o; o.x = pkbf(S[x][4 * i], S[x][4 * i + 1]); o.y = pkbf(S[x][4 * i + 2], S[x][4 * i + 3]);
                        *(LAS v2u*)(ST + ((vb0 + x) * 32 + r) * 272 + (kb * 32 + 8 * i + 4 * hh) * 2) = o; }
            }
        }
        if (OUT) {
            float ssq = 0.f;
#pragma unroll
            for (int q = 0; q < 16; ++q) ssq += accO[q] * accO[q];
            ssq += __shfl_xor(ssq, 32);
            if (hh == 0) ssqb[vb * 64 + tb * 32 + r] = ssq;
        }
        __syncthreads();
        if (OUT) {
            const int tl = tb * 32 + r;
            const float tot = (ssqb[tl] + ssqb[64 + tl]) + (ssqb[128 + tl] + ssqb[192 + tl]);
            const float rs = rsqrtf(tot * (1.0f / 128.0f) + EPS);
#pragma unroll
            for (int i = 0; i < 4; ++i) { const int v0 = vb * 32 + 8 * i + 4 * hh;
                const v2u gw = *(const v2u*)(G + (size_t)(row0 + tl) * 512 + h * 128 + v0); const f32x4 nw = *(const f32x4*)(gbo + h * 128 + v0);
                v2u o; o.x = pkbf(accO[4 * i] * rs * nw[0] * bf_lo(gw.x), accO[4 * i + 1] * rs * nw[1] * bf_hi(gw.x));
                o.y = pkbf(accO[4 * i + 2] * rs * nw[2] * bf_lo(gw.y), accO[4 * i + 3] * rs * nw[3] * bf_hi(gw.y));
                *(v2u*)(Y + (size_t)(row0 + tl) * 1024 + 512 + h * 128 + v0) = o; }
        }
    }
    if (!OUT) {
        float* sl = SLOC + (size_t)(bh * 16 + sc) * 16384;
#pragma unroll
        for (int x = 0; x < 2; ++x)
#pragma unroll
            for (int q = 0; q < 16; ++q) { const int k = kb * 32 + (q & 3) + 8 * (q >> 2) + 4 * hh; sl[(size_t)k * 128 + (vb0 + x) * 32 + r] = S[x][q]; }
        if (part == 0) DTOT[(size_t)(bh * 16 + sc) * 128 + ch] = __expf(btot);
    }
}

#define RLX_AGENT __ATOMIC_RELAXED, __HIP_MEMORY_SCOPE_AGENT
#define XB_TMO      128
#define XB_XCNT(j)  (256  + 64 * (j))
#define XB_XSUB(j)  (1280 + 64 * (j))
#define XB_XGEN(j)  (2304 + 64 * (j))
#define XB_TOP      3328
#define XB_TOPGEN   3392
#define XCD_BAR_WORDS 3456
#define XB_SPIN_CAP (1u << 18)

__device__ __forceinline__ unsigned xb_ld(unsigned* p)              { return __hip_atomic_load(p, __ATOMIC_RELAXED, __HIP_MEMORY_SCOPE_AGENT); }
__device__ __forceinline__ unsigned xb_add(unsigned* p, unsigned v) { return __hip_atomic_fetch_add(p, v, __ATOMIC_RELAXED, __HIP_MEMORY_SCOPE_AGENT); }
__device__ __forceinline__ unsigned xb_xcc_id() { return (unsigned)__builtin_amdgcn_s_getreg((3 << 11) | 20) & 0xFu; }
#define XB_SPIN(cond, bar) do { unsigned _sp = 0; while (cond) { __builtin_amdgcn_s_sleep(1); \
    if ((++_sp & 255u) == 0u) { if (xb_ld(&(bar)[XB_TMO])) break; if (_sp > XB_SPIN_CAP) { atomicAdd(&(bar)[XB_TMO], 1u); break; } } } } while (0)

struct XcdBarrier {
    unsigned* bar; unsigned x;
    volatile LAS unsigned* st;
};

__device__ __forceinline__ XcdBarrier xcd_barrier_post(unsigned* bar, volatile LAS unsigned* st) {
    XcdBarrier b; b.bar = bar; b.x = xb_xcc_id(); b.st = st;
    if (threadIdx.x == 0) (void)xb_add(&bar[XB_XCNT(b.x)], 1u);
    return b;
}
__device__ __forceinline__ void xcd_barrier_complete(unsigned* bar, unsigned x, unsigned& nloc, unsigned& nx) {
    const unsigned G = gridDim.x * gridDim.y * gridDim.z;
    unsigned sum, cnt, mine, sp = 0u;
    for (;;) {
        sum = 0u; cnt = 0u; mine = 0u;
#pragma unroll
        for (unsigned j = 0; j < 16; ++j) { const unsigned c = xb_ld(&bar[XB_XCNT(j)]); sum += c; cnt += (c > 0u) ? 1u : 0u; mine = (j == x) ? c : mine; }
        if (sum == G) break;
        __builtin_amdgcn_s_sleep(1);
        if ((++sp & 255u) == 0u) { if (xb_ld(&bar[XB_TMO])) break; if (sp > XB_SPIN_CAP) { atomicAdd(&bar[XB_TMO], 1u); break; } }
    }
    nloc = mine > 0u ? mine : 1u; nx = cnt > 0u ? cnt : 1u;
}

__device__ __forceinline__ void xcd_barrier(const XcdBarrier& b) {
    asm volatile("s_waitcnt vmcnt(0)" ::: "memory");
    __syncthreads();
    if (threadIdx.x == 0) {
        unsigned* bar = b.bar;
        __builtin_amdgcn_s_waitcnt(0);
        unsigned nloc = b.st[0], nx = b.st[1];
        if (nloc == 0u) { xcd_barrier_complete(bar, b.x, nloc, nx); b.st[0] = nloc; b.st[1] = nx; }
        const unsigned old = xb_add(&bar[XB_XSUB(b.x)], 1u);
        const unsigned gen = old / nloc;
        if (old + 1u == (gen + 1u) * nloc) {
            __builtin_amdgcn_fence(__ATOMIC_RELEASE, "agent");
            asm volatile("s_waitcnt vmcnt(0)" ::: "memory");
            const unsigned og = xb_add(&bar[XB_TOP], 1u);
            const unsigned tg = og / nx;
            if (og + 1u == (tg + 1u) * nx) xb_add(&bar[XB_TOPGEN], 1u);
            else XB_SPIN(xb_ld(&bar[XB_TOPGEN]) == tg, bar);
            __builtin_amdgcn_fence(__ATOMIC_ACQUIRE, "agent");
            xb_add(&bar[XB_XGEN(b.x)], 1u);
            asm volatile("s_waitcnt vmcnt(0)" ::: "memory");
        } else {
            XB_SPIN(xb_ld(&bar[XB_XGEN(b.x)]) == gen, bar);
            __builtin_amdgcn_fence(__ATOMIC_ACQUIRE, "agent");
            asm volatile("s_waitcnt vmcnt(0)" ::: "memory");
        }
    }
    __syncthreads();
}

__global__ void __launch_bounds__(NTHR, 2) fwd_megakernel(Args a) {
    extern __shared__ __attribute__((aligned(16))) unsigned char lds_raw[];
    LAS unsigned char* lds = (LAS unsigned char*)lds_raw;
    cg::grid_group grid = cg::this_grid();
    const int tid = threadIdx.x, G_ = gridDim.x;
    const int lo = a.ph_lo, hi = a.ph_hi;
    unsigned char* ws = a.ws;
#define IN(k) (lo <= (k) && (k) < hi)
#define SEAM(k) do { if (IN(k) && IN((k) + 1)) { for (int rs_ = 0; rs_ < REP_SYNC; ++rs_) { xcd_barrier(bar); } } } while (0)
    volatile LAS unsigned* bst = (volatile LAS unsigned*)(lds + 131072 + 256);
    if (tid < 4) bst[tid] = 0u;
    __syncthreads();
    XcdBarrier bar = xcd_barrier_post((unsigned*)(ws + WS_BAR), bst);
    if (a.ph_lo < 0) grid.sync();
    float* rowss = (float*)(ws + WS_SS);
    bf16* XB = (bf16*)(ws + WS_XB); bf16* HB = (bf16*)(ws + WS_H);
    bf16* Ub = (bf16*)(ws + WS_U); bf16* Vb = (bf16*)(ws + WS_V); bf16* Qb = (bf16*)(ws + WS_Q); float* LFb = (float*)(ws + WS_LF); bf16* Ib = (bf16*)(ws + WS_I); bf16* Gb = (bf16*)(ws + WS_G);
    bf16* Yb = (bf16*)(ws + WS_Y); float* SLOC = (float*)(ws + WS_SLOC); float* DTOT = (float*)(ws + WS_DTOT);

#ifndef SKIP_P0
    if (IN(0)) { for (int rp_ = 0; rp_ < REP_P0; ++rp_) { p0_prologue(a, lds, tid); __syncthreads(); } }
#endif
    SEAM(0);
    for (int l = 0; l < 2; ++l) {
        const int p = 1 + 6 * l;
        unsigned char* wl = ws + WS_W + (size_t)l * W_LAYER;
#ifndef SKIP_G1
        if (IN(p)) for (int rg_ = 0; rg_ < REP_G13; ++rg_) {
            pg8::Gemm g{XB, (const bf16*)(wl + W_IN), M, DIN, D}; pg8::StaticOrder S; S.init(M, DIN, G_, (int)blockIdx.x);
            pg8::EpiIn E{rowss + (size_t)(2 * l) * M, (const float*)(ws + WS_LB) + l * 512, Ub, Vb, Qb, LFb, Ib, Gb};
            pg8::gemm_phase<pg8::EpiIn, pg8::StaticOrder, true, true>(lds, g, S, E);
        }
#endif
        SEAM(p);
#ifndef SKIP_MIX1
        if (IN(p + 1)) for (int rm_ = 0; rm_ < REP_MIX; ++rm_) {
            for (int it = blockIdx.x; it < 256; it += G_)
                hgrn_item<false>(lds, it, Qb, LFb, Ib, Gb, a.in[8] + l * 512, SLOC, DTOT, Yb, tid);
            for (int it = blockIdx.x; it < 512; it += G_)
                gmlp_item(lds, it, Ub, Vb, a.in[3] + (size_t)l * 4 * 128 * 128, a.in[4] + l * 512, a.in[5] + l * 512, a.in[6] + l * 512, Yb, tid);
            __syncthreads();
        }
#endif
        SEAM(p + 1);
#ifndef SKIP_MIX2
        if (IN(p + 2)) for (int rm_ = 0; rm_ < REP_MIX; ++rm_) {
            for (int it = blockIdx.x; it < 256; it += G_)
                hgrn_item<true>(lds, it, Qb, LFb, Ib, Gb, a.in[8] + l * 512, SLOC, DTOT, Yb, tid);
            __syncthreads();
        }
#endif
        SEAM(p + 2);
#ifndef SKIP_G2
        if (IN(p + 3)) {
            pg8::Gemm g{Yb, (const bf16*)(wl + W_OUT), M, D, D}; pg8::StaticOrder S; S.init(M, D, G_, (int)blockIdx.x);
            pg8::EpiRes E{l == 0 ? a.in[0] : a.out, a.out, XB, rowss + (size_t)(2 * l + 1) * M};
            pg8::gemm_phase<pg8::EpiRes, pg8::StaticOrder, false, true>(lds, g, S, E);
        }
#endif
        SEAM(p + 3);
#ifndef SKIP_G3
        if (IN(p + 4)) for (int rg_ = 0; rg_ < REP_G13; ++rg_) {
            pg8::Gemm g{XB, (const bf16*)(wl + W_UP), M, DFF, D}; pg8::StaticOrder S; S.init(M, DFF, G_, (int)blockIdx.x);
            pg8::EpiSq E{rowss + (size_t)(2 * l + 1) * M, HB, DFF};
            pg8::gemm_phase<pg8::EpiSq, pg8::StaticOrder, true, true>(lds, g, S, E);
        }
#endif
        SEAM(p + 4);
#ifndef SKIP_G4
        if (IN(p + 5)) {
            pg8::Gemm g{HB, (const bf16*)(wl + W_DOWN), M, D, DFF}; pg8::StaticOrder S; S.init(M, D, G_, (int)blockIdx.x);
            pg8::EpiRes E{a.out, a.out, XB, rowss + (size_t)(2 * l + 2) * M};
            pg8::gemm_phase<pg8::EpiRes, pg8::StaticOrder, false, true>(lds, g, S, E);
        }
#endif
        SEAM(p + 5);
    }
    if (IN(13)) {
        const int lane = tid & 63, wave = tid >> 6; const float* ssf = rowss + (size_t)4 * M; const f32x4* nf = (const f32x4*)a.in[13] + lane;
        for (int m = blockIdx.x * NWAVES + wave; m < M; m += G_ * NWAVES) {
            const float rs = rsqrtf(ssf[m] * (1.0f / 1024.0f) + EPS);
            f32x4* xr = (f32x4*)(a.out + (size_t)m * D) + lane;
#pragma unroll
            for (int j = 0; j < 4; ++j) { const f32x4 v = xr[64 * j]; xr[64 * j] = v * rs * nf[64 * j]; }
        }
    }
#undef IN
#undef SEAM
}

extern "C" void kernel_launch(void* const* d_in, const int* in_sizes, int n_in, void* d_out, int out_size, void* d_ws, size_t ws_size, hipStream_t stream) {
    static int grid = 0;
    if (grid == 0) {
        if (n_in != 14 || in_sizes[0] != M * D || out_size != M * D || ws_size < WS_END) { fprintf(stderr, "kernel_launch: unexpected shapes (n_in %d, in0 %d, out %d, ws %zu)\n", n_in, n_in > 0 ? in_sizes[0] : -1, out_size, ws_size); grid = -1; return; }
        int dev = 0, cus = 0, per_cu = 0;
        if (hipGetDevice(&dev) != hipSuccess || hipDeviceGetAttribute(&cus, hipDeviceAttributeMultiprocessorCount, dev) != hipSuccess) { grid = -1; return; }
        if (hipFuncSetAttribute((const void*)fwd_megakernel, hipFuncAttributeMaxDynamicSharedMemorySize, LDS_BYTES) != hipSuccess) { fprintf(stderr, "kernel_launch: hipFuncSetAttribute failed\n"); grid = -1; return; }
        if (hipOccupancyMaxActiveBlocksPerMultiprocessor(&per_cu, (const void*)fwd_megakernel, NTHR, LDS_BYTES) != hipSuccess || per_cu < 1) { fprintf(stderr, "kernel_launch: occupancy query reports %d blocks per CU\n", per_cu); (void)hipGetLastError(); grid = -1; return; }
        grid = cus;
    }
    if (grid < 0) return;
    (void)hipMemsetAsync((char*)d_ws + WS_SS, 0, CTL_ZERO_BYTES, stream);
    Args a{};
    for (int i = 0; i < 14; ++i) a.in[i] = (const float*)d_in[i];
    a.out = (float*)d_out; a.ws = (unsigned char*)d_ws;
#if MK_N_LAUNCHES == 1
    a.ph_lo = 0; a.ph_hi = NPHASE;
    void* args[] = {&a};
    hipError_t e = hipLaunchCooperativeKernel((const void*)fwd_megakernel, dim3(grid), dim3(NTHR), args, LDS_BYTES, stream);
    if (e != hipSuccess) fprintf(stderr, "kernel_launch: cooperative launch failed: %s (grid %d)\n", hipGetErrorString(e), grid);
#else
    for (int ph = 0; ph < NPHASE; ++ph) { a.ph_lo = ph; a.ph_hi = ph + 1; hipLaunchKernelGGL(fwd_megakernel, dim3(grid), dim3(NTHR), LDS_BYTES, stream, a); }
#endif
}
```

```cpp
#include <hip/hip_runtime.h>
#include <hip/hip_cooperative_groups.h>
#include <cstdio>
#include <cstdint>
namespace cg = cooperative_groups;
namespace pg8 {
#define PG8_LAS __attribute__((address_space(3)))
typedef unsigned short bf16_t;
typedef short bf16x8 __attribute__((ext_vector_type(8)));
typedef float f32x4 __attribute__((ext_vector_type(4)));
typedef unsigned u32x4 __attribute__((ext_vector_type(4)));
constexpr int BM = 256, BK = 64, HALF = 128, HTB = HALF * BK * 2  , STAGE_BYTES = 8 * HTB, NXCD = 8, WGM = 8;

__host__ __device__ __forceinline__ int lds_byte(int r, int c) { const int st = (r >> 4) * 2 + (c >> 5), rr = r & 15, cc = c & 31, ob = rr * 64 + cc * 2; return st * 1024 + (ob ^ (((ob >> 9) & 1) << 5)); }
__host__ __device__ __forceinline__ void stage_rc(int b, int& R, int& C) { const int st = b / 1024, sb = b % 1024, swz = sb ^ (((sb >> 9) & 1) << 5); R = (st >> 1) * 16 + swz / 64; C = (st & 1) * 32 + (swz % 64) / 2; }
__host__ __device__ __forceinline__ int perm32(int rho) { const int n = rho >> 4, i = rho & 15; return 8 * (i >> 2) + 4 * n + (i & 3); }

struct Unit { int pm, pn; };
struct Gemm { const bf16_t* A; const bf16_t* Bt; int M, N, K; };

struct StaticOrder {
    int nM, nN, nwg, G, c;
    __host__ __device__ void init(int M, int N, int G_, int c_) { nM = M / BM; nN = N / BM; nwg = nM * nN; G = G_; c = c_; }
    __host__ __device__ bool next(int i, Unit& u) const {
        const long L = (long)i * G + c; if (L >= nwg) return false;
        int wgid = (int)L; { const int q = nwg / NXCD, r = nwg % NXCD, xcd = wgid % NXCD, off = wgid / NXCD; wgid = (xcd < r ? xcd * (q + 1) : r * (q + 1) + (xcd - r) * q) + off; }
        const int nig = WGM * nN, gid = wgid / nig, fm = gid * WGM, gsz = (nM - fm) < WGM ? (nM - fm) : WGM;
        u.pm = fm + ((wgid % nig) % gsz); u.pn = (wgid % nig) / gsz; return true;
    }
    __device__ __forceinline__ void a_ready(const Unit&) const {}
    __device__ __forceinline__ void done(const Unit&) const {}
};


__device__ __forceinline__ unsigned cvt_pk_bf16(float lo, float hi) { unsigned r; asm volatile("v_cvt_pk_bf16_f32 %0, %1, %2" : "=v"(r) : "v"(lo), "v"(hi)); return r; }
__device__ __forceinline__ float sigmoidf_fast(float z) { return __builtin_amdgcn_rcpf(1.0f + __expf(-z)); }
__device__ __forceinline__ float gelu_tanh(float x) { const float t = 1.5957691216057308f * (x + 0.044715f * x * x * x); return x * sigmoidf_fast(t); }

struct EpiIn {
    static constexpr bool PERM = true, AFTER_DRAIN = false;
    const float* rowss; const float* lb; bf16_t* U; bf16_t* V; bf16_t* Q; float* LF; bf16_t* I; bf16_t* G;
    __device__ __forceinline__ void operator()(const f32x4 (&acc)[2][2][4][2], const Unit& u, int wr, int wc, int fr, int fq) const {
        const int type = u.pn >> 1;
        const int row0 = u.pm * BM + wr * 64 + fr, cs = (u.pn & 1) * 256 + wc * 32 + 8 * fq;
        if (type == 3) {
            f32x4 l0[2], l1[2];
#pragma unroll
            for (int bj = 0; bj < 2; ++bj) { l0[bj] = *(const f32x4*)(lb + cs + bj * HALF); l1[bj] = *(const f32x4*)(lb + cs + bj * HALF + 4); }
#pragma unroll
            for (int ai = 0; ai < 2; ++ai)
#pragma unroll
                for (int m = 0; m < 4; ++m) { const int row = row0 + ai * HALF + m * 16; const float r = rsqrtf(rowss[row] * (1.0f / 1024.0f) + 1e-6f);
#pragma unroll
                    for (int bj = 0; bj < 2; ++bj) { f32x4 v0 = acc[ai][bj][m][0] * r, v1 = acc[ai][bj][m][1] * r;
#pragma unroll
                        for (int j = 0; j < 4; ++j) { v0[j] = __logf(l0[bj][j] + (1.0f - l0[bj][j]) * sigmoidf_fast(v0[j])); v1[j] = __logf(l1[bj][j] + (1.0f - l1[bj][j]) * sigmoidf_fast(v1[j])); }
                        float* p = LF + (size_t)row * 512 + cs + bj * HALF; *(f32x4*)p = v0; *(f32x4*)(p + 4) = v1; } }
        } else {
            bf16_t* ob = type == 0 ? U : type == 1 ? V : type == 2 ? Q : type == 4 ? I : G;
#pragma unroll
            for (int ai = 0; ai < 2; ++ai)
#pragma unroll
                for (int m = 0; m < 4; ++m) { const int row = row0 + ai * HALF + m * 16; const float r = rsqrtf(rowss[row] * (1.0f / 1024.0f) + 1e-6f);
#pragma unroll
                    for (int bj = 0; bj < 2; ++bj) { f32x4 v0 = acc[ai][bj][m][0] * r, v1 = acc[ai][bj][m][1] * r;
                        if (type <= 1) {
#pragma unroll
                            for (int j = 0; j < 4; ++j) { v0[j] = gelu_tanh(v0[j]); v1[j] = gelu_tanh(v1[j]); } }
                        else if (type == 5) {
#pragma unroll
                            for (int j = 0; j < 4; ++j) { v0[j] = v0[j] * sigmoidf_fast(v0[j]); v1[j] = v1[j] * sigmoidf_fast(v1[j]); } }
                        u32x4 w; w.x = cvt_pk_bf16(v0[0], v0[1]); w.y = cvt_pk_bf16(v0[2], v0[3]); w.z = cvt_pk_bf16(v1[0], v1[1]); w.w = cvt_pk_bf16(v1[2], v1[3]);
                        *(u32x4*)(ob + (size_t)row * 512 + cs + bj * HALF) = w; } }
        }
    }
};
struct EpiSq {
    static constexpr bool PERM = true, AFTER_DRAIN = false;
    const float* rowss; bf16_t* O; int ldc;
    __device__ __forceinline__ void operator()(const f32x4 (&acc)[2][2][4][2], const Unit& u, int wr, int wc, int fr, int fq) const {
        const int row0 = u.pm * BM + wr * 64 + fr, col0 = u.pn * BM + wc * 32 + 8 * fq;
#pragma unroll
        for (int ai = 0; ai < 2; ++ai)
#pragma unroll
            for (int m = 0; m < 4; ++m) { const int row = row0 + ai * HALF + m * 16; const float r = rsqrtf(rowss[row] * (1.0f / 1024.0f) + 1e-6f);
#pragma unroll
                for (int bj = 0; bj < 2; ++bj) { f32x4 v0 = acc[ai][bj][m][0] * r, v1 = acc[ai][bj][m][1] * r;
#pragma unroll
                    for (int j = 0; j < 4; ++j) { const float a = fmaxf(v0[j], 0.f), b = fmaxf(v1[j], 0.f); v0[j] = a * a; v1[j] = b * b; }
                    u32x4 w; w.x = cvt_pk_bf16(v0[0], v0[1]); w.y = cvt_pk_bf16(v0[2], v0[3]); w.z = cvt_pk_bf16(v1[0], v1[1]); w.w = cvt_pk_bf16(v1[2], v1[3]);
                    *(u32x4*)(O + (size_t)row * ldc + col0 + bj * HALF) = w; } }
    }
};
struct EpiRes {
    static constexpr bool PERM = true, AFTER_DRAIN = false;
    const float* xin; float* xout; bf16_t* xb; float* ss_out;
    __device__ __forceinline__ void operator()(const f32x4 (&acc)[2][2][4][2], const Unit& u, int wr, int wc, int fr, int fq) const {
        const int row0 = u.pm * BM + wr * 64 + fr, col0 = u.pn * BM + wc * 32 + 8 * fq;
#pragma unroll
        for (int ai = 0; ai < 2; ++ai)
#pragma unroll
            for (int m = 0; m < 4; ++m) { const int row = row0 + ai * HALF + m * 16; float ss = 0.f;
#pragma unroll
                for (int bj = 0; bj < 2; ++bj) { const size_t off = (size_t)row * 1024 + col0 + bj * HALF;
                    const f32x4 a0 = *(const f32x4*)(xin + off), a1 = *(const f32x4*)(xin + off + 4);
                    const f32x4 o0 = a0 + acc[ai][bj][m][0], o1 = a1 + acc[ai][bj][m][1];
                    *(f32x4*)(xout + off) = o0; *(f32x4*)(xout + off + 4) = o1;
                    u32x4 w; w.x = cvt_pk_bf16(o0[0], o0[1]); w.y = cvt_pk_bf16(o0[2], o0[3]); w.z = cvt_pk_bf16(o1[0], o1[1]); w.w = cvt_pk_bf16(o1[2], o1[3]);
                    *(u32x4*)(xb + off) = w;
                    ss += (o0[0] * o0[0] + o0[1] * o0[1]) + (o0[2] * o0[2] + o0[3] * o0[3]) + (o1[0] * o1[0] + o1[1] * o1[1]) + (o1[2] * o1[2] + o1[3] * o1[3]); }
                ss += __shfl_xor(ss, 16); ss += __shfl_xor(ss, 32);
                if (fq == 0) atomicAdd(ss_out + row, ss); }
    }
};

template <class Epi, class Sched, bool ALIGN_EPI = false, bool SP2 = false>
__device__ __forceinline__ void gemm_phase(PG8_LAS unsigned char* lds, const Gemm g, const Sched& S, const Epi& E) {
    int tid_ = threadIdx.x; asm volatile("" : "+v"(tid_));
    const int tid = tid_, wid = __builtin_amdgcn_readfirstlane(tid >> 6), lane = tid & 63, wr = wid >> 2, wc = wid & 3, fr = lane & 15, fq = lane >> 4;
    const int K = g.K, nt = K / BK;
    unsigned voffA[2], voffB[2];
#pragma unroll
    for (int i = 0; i < 2; ++i) { int R, C; stage_rc(tid * 16 + i * 8192, R, C); const int Rb = Epi::PERM ? ((R & ~31) + perm32(R & 31)) : R;
        voffA[i] = (unsigned)(R * K + C) * 2u; voffB[i] = (unsigned)(Rb * K + C) * 2u; }
    const size_t kstep = (size_t)(BK * 2);
    const size_t hstep = (size_t)HALF * K * 2;
    const size_t tstep = 2 * hstep;
    const unsigned ldsw = (unsigned)wid * 1024u;
    const int aoff = lds_byte(wr * 64 + fr, fq * 8), boff = lds_byte(wc * 32 + fr, fq * 8);
#define PG8_SA(b, h) (((b) * 2 + (h)) * HTB)
#define PG8_SB(b, h) ((4 + (b) * 2 + (h)) * HTB)
#define PG8_STAGE(bufoff, gbase, voff) do { _Pragma("unroll") for (int _i = 0; _i < 2; ++_i) \
        __builtin_amdgcn_global_load_lds((const unsigned*)((const char*)(gbase) + (voff)[_i]), (PG8_LAS unsigned*)(lds + (bufoff) + ldsw + _i * 8192), 16, 0, 0); } while (0)
#define PG8_LDA(dst, b, h) do { _Pragma("unroll") for (int m = 0; m < 4; ++m) _Pragma("unroll") for (int k = 0; k < 2; ++k) dst[m][k] = *(const PG8_LAS bf16x8*)(lds + PG8_SA(b, h) + aoff + m * 2048 + k * 1024); } while (0)
#define PG8_LDB(dst, b, h) do { _Pragma("unroll") for (int n = 0; n < 2; ++n) _Pragma("unroll") for (int k = 0; k < 2; ++k) dst[n][k] = *(const PG8_LAS bf16x8*)(lds + PG8_SB(b, h) + boff + n * 2048 + k * 1024); } while (0)
#define PG8_MMA(ai, bj, At, Bt) do { __builtin_amdgcn_s_setprio(1); _Pragma("unroll") for (int m = 0; m < 4; ++m) _Pragma("unroll") for (int n = 0; n < 2; ++n) _Pragma("unroll") for (int k = 0; k < 2; ++k) \
        acc[ai][bj][m][n] = __builtin_amdgcn_mfma_f32_16x16x32_bf16(Bt[n][k], At[m][k], acc[ai][bj][m][n], 0, 0, 0); __builtin_amdgcn_s_setprio(0); } while (0)
#define PG8_WAIT_V(n) asm volatile("s_waitcnt vmcnt(" #n ")" ::: "memory")
#define PG8_WAIT_L(n) asm volatile("s_waitcnt lgkmcnt(" #n ")" ::: "memory")
#define PG8_BAR __builtin_amdgcn_s_barrier()
#define PG8_SCHED __builtin_amdgcn_sched_barrier(0)
    Unit cur, nxt; int ui = 0;
    if (!S.next(0, cur)) return;
    f32x4 acc[2][2][4][2];
#pragma unroll
    for (int a = 0; a < 2; ++a)
#pragma unroll
        for (int b = 0; b < 2; ++b)
#pragma unroll
            for (int m = 0; m < 4; ++m)
#pragma unroll
                for (int n = 0; n < 2; ++n) acc[a][b][m][n] = (f32x4){0.f, 0.f, 0.f, 0.f};
    bf16x8 At[4][2], B0[2][2], B1[2][2];
    const char* cA = (const char*)g.A + (size_t)cur.pm * tstep; const char* cB = (const char*)g.Bt + (size_t)cur.pn * tstep;
    S.a_ready(cur);
    if constexpr (SP2) {
        PG8_STAGE(PG8_SB(0, 0), cB, voffB); PG8_STAGE(PG8_SB(0, 1), cB + hstep, voffB); PG8_STAGE(PG8_SA(0, 0), cA, voffA); PG8_STAGE(PG8_SA(0, 1), cA + hstep, voffA);
        if (wr == 1) PG8_BAR;
        PG8_WAIT_V(2); PG8_BAR;
        PG8_STAGE(PG8_SB(1, 0), cB + kstep, voffB); PG8_STAGE(PG8_SA(1, 0), cA + kstep, voffA); PG8_STAGE(PG8_SB(1, 1), cB + hstep + kstep, voffB);
        PG8_WAIT_V(6); PG8_BAR;
    } else {
        PG8_STAGE(PG8_SB(0, 0), cB, voffB); PG8_STAGE(PG8_SA(0, 0), cA, voffA); PG8_STAGE(PG8_SB(0, 1), cB + hstep, voffB); PG8_STAGE(PG8_SA(0, 1), cA + hstep, voffA);
        if (wr == 1) PG8_BAR;
        PG8_WAIT_V(4); PG8_BAR;
        PG8_STAGE(PG8_SB(1, 0), cB + kstep, voffB); PG8_STAGE(PG8_SA(1, 0), cA + kstep, voffA); PG8_STAGE(PG8_SB(1, 1), cB + hstep + kstep, voffB);
        PG8_WAIT_V(6); PG8_BAR;
    }
    for (;;) {
        const bool has_next = S.next(ui + 1, nxt);
        const char* nA = has_next ? (const char*)g.A + (size_t)nxt.pm * tstep : cA; const char* nB = has_next ? (const char*)g.Bt + (size_t)nxt.pn * tstep : cB;
        for (int t = 0; t < nt; t += 2) {
            const bool last = (t == nt - 2);
            const char* a1 = cA + (size_t)(t + 1) * kstep;
            const char* a2 = last ? nA : cA + (size_t)(t + 2) * kstep; const char* b2 = last ? nB : cB + (size_t)(t + 2) * kstep;
            const char* a3 = a2 + kstep; const char* b3 = b2 + kstep;
            if (last && has_next) S.a_ready(nxt);
            if constexpr (SP2) {
            PG8_LDB(B0, 0, 0); PG8_LDB(B1, 0, 1); PG8_SCHED; PG8_LDA(At, 0, 0); PG8_STAGE(PG8_SA(1, 1), a1 + hstep, voffA);
            PG8_WAIT_V(8); PG8_WAIT_L(0); PG8_BAR; PG8_MMA(0, 0, At, B0); PG8_MMA(0, 1, At, B1); PG8_BAR; PG8_SCHED;
            PG8_LDA(At, 0, 1); PG8_STAGE(PG8_SB(0, 0), b2, voffB); PG8_STAGE(PG8_SB(0, 1), b2 + hstep, voffB); PG8_STAGE(PG8_SA(0, 0), a2, voffA);
            PG8_WAIT_V(8); PG8_WAIT_L(0); PG8_BAR; PG8_MMA(1, 0, At, B0); PG8_MMA(1, 1, At, B1); PG8_BAR; PG8_SCHED;
            PG8_LDB(B0, 1, 0); PG8_LDB(B1, 1, 1); PG8_SCHED; PG8_LDA(At, 1, 0); PG8_STAGE(PG8_SA(0, 1), a2 + hstep, voffA);
            PG8_WAIT_V(8); PG8_WAIT_L(0); PG8_BAR; PG8_MMA(0, 0, At, B0); PG8_MMA(0, 1, At, B1); PG8_BAR; PG8_SCHED;
            PG8_LDA(At, 1, 1); PG8_STAGE(PG8_SB(1, 0), b3, voffB); PG8_STAGE(PG8_SB(1, 1), b3 + hstep, voffB); PG8_STAGE(PG8_SA(1, 0), a3, voffA);
            PG8_WAIT_V(8); PG8_WAIT_L(0); PG8_BAR; PG8_MMA(1, 0, At, B0); PG8_MMA(1, 1, At, B1); PG8_BAR; PG8_SCHED;
            } else {
            PG8_LDB(B0, 0, 0); PG8_SCHED; PG8_LDA(At, 0, 0); PG8_STAGE(PG8_SA(1, 1), a1 + hstep, voffA);
            PG8_WAIT_L(8); PG8_BAR; PG8_WAIT_L(0); PG8_MMA(0, 0, At, B0); PG8_BAR; PG8_SCHED;
            PG8_LDB(B1, 0, 1); PG8_STAGE(PG8_SB(0, 0), b2, voffB);
            PG8_BAR; PG8_WAIT_L(0); PG8_MMA(0, 1, At, B1); PG8_BAR;
            PG8_LDA(At, 0, 1); PG8_STAGE(PG8_SA(0, 0), a2, voffA);
            PG8_BAR; PG8_WAIT_L(0); PG8_MMA(1, 0, At, B0); PG8_BAR; PG8_SCHED;
            PG8_STAGE(PG8_SB(0, 1), b2 + hstep, voffB);
            PG8_WAIT_V(6); PG8_BAR; PG8_MMA(1, 1, At, B1); PG8_BAR;
            PG8_LDB(B0, 1, 0); PG8_SCHED; PG8_LDA(At, 1, 0); PG8_STAGE(PG8_SA(0, 1), a2 + hstep, voffA);
            PG8_WAIT_L(8); PG8_BAR; PG8_WAIT_L(0); PG8_MMA(0, 0, At, B0); PG8_BAR; PG8_SCHED;
            PG8_LDB(B1, 1, 1); PG8_STAGE(PG8_SB(1, 0), b3, voffB);
            PG8_BAR; PG8_WAIT_L(0); PG8_MMA(0, 1, At, B1); PG8_BAR;
            PG8_LDA(At, 1, 1); PG8_STAGE(PG8_SA(1, 0), a3, voffA);
            PG8_BAR; PG8_WAIT_L(0); PG8_MMA(1, 0, At, B0); PG8_BAR; PG8_SCHED;
            PG8_STAGE(PG8_SB(1, 1), b3 + hstep, voffB);
            PG8_WAIT_V(6); PG8_BAR; PG8_MMA(1, 1, At, B1); PG8_BAR;
            }
        }
        if constexpr (ALIGN_EPI) { if (wr == 0) PG8_BAR; }
        if constexpr (!Epi::AFTER_DRAIN) { E(acc, cur, wr, wc, fr, fq); S.done(cur); }
        if (!has_next) break;
#pragma unroll
        for (int a = 0; a < 2; ++a)
#pragma unroll
            for (int b = 0; b < 2; ++b)
#pragma unroll
                for (int m = 0; m < 4; ++m)
#pragma unroll
                    for (int n = 0; n < 2; ++n) acc[a][b][m][n] = (f32x4){0.f, 0.f, 0.f, 0.f};
        cur = nxt; cA = nA; cB = nB; ++ui;
        if constexpr (ALIGN_EPI) { if (wr == 1) PG8_BAR; }
    }
    PG8_WAIT_V(0);
    if constexpr (!ALIGN_EPI) { if (wr == 0) PG8_BAR; }
    PG8_BAR;
    if constexpr (Epi::AFTER_DRAIN) { E.fused(acc, cur, wr, wc, fr, fq, lds, wid, lane); S.done(cur); }
#undef PG8_SA
#undef PG8_SB
#undef PG8_STAGE
#undef PG8_LDA
#undef PG8_LDB
#undef PG8_MMA
#undef PG8_WAIT_V
#undef PG8_WAIT_L
#undef PG8_BAR
#undef PG8_SCHED
}
}

#ifndef MK_N_LAUNCHES
#define MK_N_LAUNCHES 1
#endif
#ifndef REP_MIX
#define REP_MIX 1
#endif
#ifndef REP_G13
#define REP_G13 1
#endif
#ifndef REP_SYNC
#define REP_SYNC 1
#endif
#ifndef REP_P0
#define REP_P0 1
#endif
constexpr int NWAVES = 8, NTHR = 512;
constexpr int M = 16384, D = 1024, DIN = 3072, DFF = 4096, SEQ = 4096;
constexpr int NPHASE = 14;
constexpr float EPS = 1e-6f;
constexpr size_t MiB = 1u << 20;
constexpr size_t WS_SS = 0, SS_BYTES = 5 * (size_t)M * 4;
constexpr size_t WS_BAR = 384 * 1024;
constexpr size_t CTL_ZERO_BYTES = 448 * 1024;
constexpr size_t WS_LB = 512 * 1024;
constexpr size_t WS_W = 1 * MiB, W_LAYER = 24 * MiB, W_IN = 0, W_OUT = 6 * MiB, W_UP = 8 * MiB, W_DOWN = 16 * MiB;
constexpr size_t WS_XB = 49 * MiB;
constexpr size_t WS_H = 81 * MiB;
constexpr size_t WS_U = 81 * MiB, WS_V = 97 * MiB, WS_Q = 113 * MiB, WS_LF = 129 * MiB, WS_I = 161 * MiB, WS_G = 177 * MiB, WS_Y = 193 * MiB, WS_SLOC = 225 * MiB, WS_DTOT = 241 * MiB;
constexpr size_t WS_END = 242 * MiB;
constexpr int LDS_BYTES = 147456;

#define LAS __attribute__((address_space(3)))
typedef unsigned short bf16;
typedef unsigned v4u __attribute__((ext_vector_type(4)));
typedef unsigned v2u __attribute__((ext_vector_type(2)));
typedef float f32x4 __attribute__((ext_vector_type(4)));
typedef float f32x16 __attribute__((ext_vector_type(16)));
typedef short bf16x8 __attribute__((ext_vector_type(8)));
#define LDS_WAIT() asm volatile("s_waitcnt lgkmcnt(0)" ::: "memory")
__device__ __forceinline__ unsigned pkbf(float lo, float hi) { return pg8::cvt_pk_bf16(lo, hi); }
__device__ __forceinline__ float bf_lo(unsigned w) { return __uint_as_float(w << 16); }
__device__ __forceinline__ float bf_hi(unsigned w) { return __uint_as_float(w & 0xffff0000u); }
__device__ __forceinline__ float bf1(bf16 v) { return __uint_as_float(((unsigned)v) << 16); }
__device__ __forceinline__ bf16 tobf(float f) { return (bf16)(pg8::cvt_pk_bf16(f, 0.f) & 0xffffu); }
__device__ __forceinline__ float wave_sum(float v) {
#pragma unroll
    for (int o = 1; o < 64; o <<= 1) v += __shfl_xor(v, o);
    return v;
}

__device__ __forceinline__ void p0_transpose_item(const float* W, int K, int N, bf16* WT, const float* ksc, LAS float* scr, int item, int lane) {
    const int nblk = N / 32, kb = item / nblk, nb = item % nblk, k0 = 64 * kb, n0 = 32 * nb;
    const int kr = lane >> 3, n4 = (lane & 7) * 4;
    f32x4 v[8];
#pragma unroll
    for (int i = 0; i < 8; ++i) v[i] = *(const f32x4*)(W + (size_t)(k0 + 8 * i + kr) * N + n0 + n4);
#pragma unroll
    for (int i = 0; i < 8; ++i) { const int kk = 8 * i + kr; const float s = ksc ? ksc[k0 + kk] : 1.0f; LAS float* d = scr + kk * 33 + n4;
        d[0] = v[i].x * s; d[1] = v[i].y * s; d[2] = v[i].z * s; d[3] = v[i].w * s; }
    LDS_WAIT(); asm volatile("" ::: "memory");
    const int c = lane & 7;
#pragma unroll
    for (int j = 0; j < 4; ++j) { const int n = (lane >> 3) + 8 * j; const LAS float* sp = scr + (8 * c) * 33 + n;
        v4u o; o.x = pkbf(sp[0 * 33], sp[1 * 33]); o.y = pkbf(sp[2 * 33], sp[3 * 33]); o.z = pkbf(sp[4 * 33], sp[5 * 33]); o.w = pkbf(sp[6 * 33], sp[7 * 33]);
        *(v4u*)(WT + (size_t)(n0 + n) * K + k0 + 8 * c) = o; }
    LDS_WAIT(); asm volatile("" ::: "memory");
}

struct Args { const float* in[14]; float* out; unsigned char* ws; int ph_lo, ph_hi; };

__device__ __forceinline__ void p0_prologue(const Args& a, LAS unsigned char* lds, int tid_) {
    int tid = tid_; asm volatile("" : "+v"(tid));
    const int lane = tid & 63, wave = tid >> 6;
    LAS float* scr = (LAS float*)(lds + wave * 16384);
    const int gw = blockIdx.x * NWAVES + wave, NGW = gridDim.x * NWAVES;
    constexpr int I_IN = (D / 64) * (DIN / 32), I_OUT = (D / 64) * (D / 32), I_UP = (D / 64) * (DFF / 32), I_DN = (DFF / 64) * (D / 32), I_L = I_IN + I_OUT + I_UP + I_DN;
    for (int it = gw; it < 2 * I_L; it += NGW) {
        const int l = it / I_L; int r = it % I_L;
        unsigned char* wl = a.ws + WS_W + (size_t)l * W_LAYER;
        if (r < I_IN) { p0_transpose_item(a.in[2] + (size_t)l * D * DIN, D, DIN, (bf16*)(wl + W_IN), a.in[1] + l * D, scr, r, lane); continue; } r -= I_IN;
        if (r < I_OUT) { p0_transpose_item(a.in[9] + (size_t)l * D * D, D, D, (bf16*)(wl + W_OUT), nullptr, scr, r, lane); continue; } r -= I_OUT;
        if (r < I_UP) { p0_transpose_item(a.in[11] + (size_t)l * D * DFF, D, DFF, (bf16*)(wl + W_UP), a.in[10] + l * D, scr, r, lane); continue; } r -= I_UP;
        p0_transpose_item(a.in[12] + (size_t)l * DFF * D, DFF, D, (bf16*)(wl + W_DOWN), nullptr, scr, r, lane);
    }
    bf16* XB = (bf16*)(a.ws + WS_XB); float* ss0 = (float*)(a.ws + WS_SS);
    for (int m = gw; m < M; m += NGW) {
        const f32x4* xr = (const f32x4*)(a.in[0] + (size_t)m * D) + lane; float s = 0.f;
        unsigned long long* o8 = (unsigned long long*)(XB + (size_t)m * D) + lane;
#pragma unroll
        for (int j = 0; j < 4; ++j) { const f32x4 v = xr[64 * j]; s += (v.x * v.x + v.y * v.y) + (v.z * v.z + v.w * v.w);
            o8[64 * j] = (unsigned long long)pkbf(v.x, v.y) | ((unsigned long long)pkbf(v.z, v.w) << 32); }
        s = wave_sum(s);
        if (lane == 0) ss0[m] = s;
    }
    if (blockIdx.x == 0) { float* lbv = (float*)(a.ws + WS_LB); const float* lw = a.in[7];
        for (int c = tid; c < 512; c += NTHR) { const float a0 = lw[c], a1 = lw[512 + c]; lbv[c] = 0.f; lbv[512 + c] = 1.0f / (1.0f + expf(a0 - a1)); } }
}

__device__ __forceinline__ void gmlp_stage_w(LAS unsigned char* lds, const float* Wsp, int g, int tid_) {
    int tid = tid_; asm volatile("" : "+v"(tid));
    LAS unsigned char* WL = lds + 40960;
    __syncthreads();
#pragma unroll
    for (int i = 0; i < 8; ++i) { const int idx = tid + 512 * i, t = idx >> 5, c4 = (idx & 31) * 4;
        const f32x4 v = *(const f32x4*)(Wsp + (size_t)(g * 128 + t) * 128 + c4);
        v2u o; o.x = pkbf(c4 <= t ? v.x : 0.f, c4 + 1 <= t ? v.y : 0.f); o.y = pkbf(c4 + 2 <= t ? v.z : 0.f, c4 + 3 <= t ? v.w : 0.f);
        *(LAS v2u*)(WL + t * 272 + c4 * 2) = o; }
}
__device__ __forceinline__ void gmlp_item(LAS unsigned char* lds, int item, const bf16* U, const bf16* V, const float* Wsp, const float* bsp, const float* gv, const float* go, bf16* Y, int tid_) {
    int tid = tid_; asm volatile("" : "+v"(tid));
    const int g = item & 3, row0 = (item >> 2) * 128;
    const LAS unsigned char* WL = lds + 40960;
    const int lane = tid & 63, w = tid >> 6, r = lane & 31, hh = lane >> 5;
    LAS unsigned char* VnT = lds; LAS float* red = (LAS float*)(lds + 34816); LAS float* ssqb = (LAS float*)(lds + 38912);
    __syncthreads();
    {
        const int sp = lane, cr = w;
        const bf16* vp = V + (size_t)(row0 + 2 * sp) * 512 + g * 128 + cr * 16;
        const v4u a0 = *(const v4u*)vp, a1 = *(const v4u*)(vp + 8), b0 = *(const v4u*)(vp + 512), b1 = *(const v4u*)(vp + 520);
        float va[16], vb[16];
#pragma unroll
        for (int j = 0; j < 4; ++j) { va[2 * j] = bf_lo(a0[j]); va[2 * j + 1] = bf_hi(a0[j]); va[8 + 2 * j] = bf_lo(a1[j]); va[9 + 2 * j] = bf_hi(a1[j]);
            vb[2 * j] = bf_lo(b0[j]); vb[2 * j + 1] = bf_hi(b0[j]); vb[8 + 2 * j] = bf_lo(b1[j]); vb[9 + 2 * j] = bf_hi(b1[j]); }
        float sa = 0.f, sb = 0.f;
#pragma unroll
        for (int j = 0; j < 16; ++j) { sa += va[j] * va[j]; sb += vb[j] * vb[j]; }
        red[cr * 128 + 2 * sp] = sa; red[cr * 128 + 2 * sp + 1] = sb;
        __syncthreads();
        float ta = 0.f, tb = 0.f;
#pragma unroll
        for (int k = 0; k < 8; ++k) { ta += red[k * 128 + 2 * sp]; tb += red[k * 128 + 2 * sp + 1]; }
        const float ra = rsqrtf(ta * (1.0f / 128.0f) + EPS), rb = rsqrtf(tb * (1.0f / 128.0f) + EPS);
#pragma unroll
        for (int j = 0; j < 16; ++j) { const int c = cr * 16 + j; const float gw = gv[g * 128 + c];
            *(LAS unsigned*)(VnT + c * 272 + sp * 4) = pkbf(va[j] * ra * gw, vb[j] * rb * gw); }
    }
    __syncthreads();
    const int cb = w >> 1;
    f32x16 acc[2]; float yv[2][16];
#pragma unroll
    for (int x = 0; x < 2; ++x) {
        const int tb = (w & 1) ? (x == 0 ? 1 : 2) : (x == 0 ? 0 : 3);
        const int t = tb * 32 + r;
#pragma unroll
        for (int q = 0; q < 16; ++q) acc[x][q] = 0.f;
        const int nks = (tb + 1) * 2;
        for (int ks = 0; ks < nks; ++ks) {
            const bf16x8 af = *(const LAS bf16x8*)(VnT + (cb * 32 + r) * 272 + (ks * 16 + 8 * hh) * 2);
            const bf16x8 bw = *(const LAS bf16x8*)(WL + t * 272 + (ks * 16 + 8 * hh) * 2);
            acc[x] = __builtin_amdgcn_mfma_f32_32x32x16_bf16(af, bw, acc[x], 0, 0, 0);
        }
        const float bias = bsp[g * 128 + t]; float ssq = 0.f;
#pragma unroll
        for (int i = 0; i < 4; ++i) { const int c = cb * 32 + 8 * i + 4 * hh;
            const v2u uw = *(const v2u*)(U + (size_t)(row0 + t) * 512 + g * 128 + c);
            const float u0 = bf_lo(uw.x), u1 = bf_hi(uw.x), u2 = bf_lo(uw.y), u3 = bf_hi(uw.y);
            yv[x][4 * i + 0] = u0 * (acc[x][4 * i + 0] + bias); yv[x][4 * i + 1] = u1 * (acc[x][4 * i + 1] + bias);
            yv[x][4 * i + 2] = u2 * (acc[x][4 * i + 2] + bias); yv[x][4 * i + 3] = u3 * (acc[x][4 * i + 3] + bias);
#pragma unroll
            for (int j = 0; j < 4; ++j) ssq += yv[x][4 * i + j] * yv[x][4 * i + j]; }
        ssq += __shfl_xor(ssq, 32);
        if (hh == 0) ssqb[cb * 128 + t] = ssq;
    }
    __syncthreads();
#pragma unroll
    for (int x = 0; x < 2; ++x) {
        const int tb = (w & 1) ? (x == 0 ? 1 : 2) : (x == 0 ? 0 : 3);
        const int t = tb * 32 + r;
        const float tot = (ssqb[t] + ssqb[128 + t]) + (ssqb[256 + t] + ssqb[384 + t]);
        const float rs = rsqrtf(tot * (1.0f / 128.0f) + EPS);
#pragma unroll
        for (int i = 0; i < 4; ++i) { const int c = cb * 32 + 8 * i + 4 * hh; const f32x4 gw = *(const f32x4*)(go + g * 128 + c);
            v2u o; o.x = pkbf(yv[x][4 * i] * rs * gw[0], yv[x][4 * i + 1] * rs * gw[1]); o.y = pkbf(yv[x][4 * i + 2] * rs * gw[2], yv[x][4 * i + 3] * rs * gw[3]);
            *(v2u*)(Y + (size_t)(row0 + t) * 1024 + g * 128 + c) = o; }
    }
}

template <bool OUT>
__device__ __forceinline__ void hgrn_item(LAS unsigned char* lds, int item, const bf16* Q, const float* LF, const bf16* I, const bf16* G, const float* gbo, float* SLOC, float* DTOT, bf16* Y, int tid_) {
    int tid = tid_; asm volatile("" : "+v"(tid));
    const int sc = item & 15, bh = item >> 4, b = bh >> 2, h = bh & 3;
    const int rowbase = b * SEQ + sc * 256;
    const int lane = tid & 63, w = tid >> 6, r = lane & 31, hh = lane >> 5;
    LAS unsigned char* Q1s = lds; LAS unsigned char* K1s = lds + 17408; LAS unsigned char* K2T = lds + 34816; LAS unsigned char* VT = lds + 53248;
    LAS unsigned char* ST = lds + 71680; LAS unsigned char* Ps = lds + 106496;
    LAS float* totb = (LAS float*)(lds + 115712); LAS float* dl = (LAS float*)(lds + 117760); LAS float* ssqb = (LAS float*)(lds + 118272);
    const int kb = w >> 1, vb0 = (w & 1) * 2;
    const int vb = w >> 1, tb = w & 1;
    f32x16 S[2];
#pragma unroll
    for (int x = 0; x < 2; ++x)
#pragma unroll
        for (int q = 0; q < 16; ++q) S[x][q] = 0.f;
    __syncthreads();
    if (OUT) {
        for (int m = 0; m < sc; ++m) {
            const float* dt = DTOT + (size_t)(bh * 16 + m) * 128; const float* sl = SLOC + (size_t)(bh * 16 + m) * 16384;
#pragma unroll
            for (int i = 0; i < 4; ++i) { const int k0 = kb * 32 + 8 * i + 4 * hh; const f32x4 d4 = *(const f32x4*)(dt + k0);
#pragma unroll
                for (int x = 0; x < 2; ++x)
#pragma unroll
                    for (int j = 0; j < 4; ++j) S[x][4 * i + j] = d4[j] * S[x][4 * i + j] + sl[(size_t)(k0 + j) * 128 + (vb0 + x) * 32 + r]; }
        }
#pragma unroll
        for (int x = 0; x < 2; ++x)
#pragma unroll
            for (int i = 0; i < 4; ++i) { v2u o; o.x = pkbf(S[x][4 * i], S[x][4 * i + 1]); o.y = pkbf(S[x][4 * i + 2], S[x][4 * i + 3]);
                *(LAS v2u*)(ST + ((vb0 + x) * 32 + r) * 272 + (kb * 32 + 8 * i + 4 * hh) * 2) = o; }
    }
    const int ch = tid & 127, part = tid >> 7;
    float btot = 0.f;
    float nlf[16]; unsigned short niv[16], nqv[16];
    {
        const size_t e0 = (size_t)(rowbase + part * 16) * 512 + h * 128 + ch;
#pragma unroll
        for (int i = 0; i < 16; ++i) { nlf[i] = LF[e0 + (size_t)i * 512]; niv[i] = I[e0 + (size_t)i * 512]; if (OUT) nqv[i] = Q[e0 + (size_t)i * 512]; }
    }
    for (int jc = 0; jc < 4; ++jc) {
        const int row0 = rowbase + jc * 64;
        float cs[16], lfv[16]; unsigned short iv[16], qv[16];
#pragma unroll
        for (int i = 0; i < 16; ++i) { cs[i] = nlf[i]; lfv[i] = nlf[i]; iv[i] = niv[i]; if (OUT) qv[i] = nqv[i]; }
#pragma unroll
        for (int i = 1; i < 16; ++i) cs[i] += cs[i - 1];
        totb[part * 128 + ch] = cs[15];
        __syncthreads();
        const float t0 = totb[ch], t1 = totb[128 + ch], t2 = totb[256 + ch], t3 = totb[384 + ch];
        const float off = (part > 0 ? t0 : 0.f) + (part > 1 ? t1 : 0.f) + (part > 2 ? t2 : 0.f);
        const float bl = (t0 + t1) + (t2 + t3);
        {
            unsigned k2w[8], vw[8];
#pragma unroll
            for (int i = 0; i < 16; i += 2) {
                const float b0 = off + cs[i], b1 = off + cs[i + 1];
                const float k0 = 1.0f - __expf(lfv[i]), k1 = 1.0f - __expf(lfv[i + 1]);
                k2w[i >> 1] = pkbf(k0 * __expf(bl - b0), k1 * __expf(bl - b1));
                vw[i >> 1] = (unsigned)iv[i] | ((unsigned)iv[i + 1] << 16);
                if (OUT) {
                    const float q0 = bf1(qv[i]) * __expf(b0), q1 = bf1(qv[i + 1]) * __expf(b1);
                    const float c0 = k0 * __expf(fminf(-b0, 80.f)), c1 = k1 * __expf(fminf(-b1, 80.f));
                    *(LAS bf16*)(Q1s + (part * 16 + i) * 272 + ch * 2) = tobf(q0); *(LAS bf16*)(Q1s + (part * 16 + i + 1) * 272 + ch * 2) = tobf(q1);
                    *(LAS bf16*)(K1s + (part * 16 + i) * 272 + ch * 2) = tobf(c0); *(LAS bf16*)(K1s + (part * 16 + i + 1) * 272 + ch * 2) = tobf(c1);
                }
            }
            *(LAS v4u*)(K2T + ch * 144 + part * 32) = (v4u){k2w[0], k2w[1], k2w[2], k2w[3]}; *(LAS v4u*)(K2T + ch * 144 + part * 32 + 16) = (v4u){k2w[4], k2w[5], k2w[6], k2w[7]};
            *(LAS v4u*)(VT + ch * 144 + part * 32) = (v4u){vw[0], vw[1], vw[2], vw[3]}; *(LAS v4u*)(VT + ch * 144 + part * 32 + 16) = (v4u){vw[4], vw[5], vw[6], vw[7]};
            if (part == 0) { dl[ch] = __expf(bl); btot += bl; }
        }
        __syncthreads();
        if (jc < 3) {
            const size_t e0 = (size_t)(row0 + 64 + part * 16) * 512 + h * 128 + ch;
#pragma unroll
            for (int i = 0; i < 16; ++i) { nlf[i] = LF[e0 + (size_t)i * 512]; niv[i] = I[e0 + (size_t)i * 512]; if (OUT) nqv[i] = Q[e0 + (size_t)i * 512]; }
        }
        f32x16 accO;
#pragma unroll
        for (int q = 0; q < 16; ++q) accO[q] = 0.f;
        if (OUT) {
            if (w < 3) {
                const int sb = (w == 2) ? 1 : 0, tbs = (w == 0) ? 0 : 1;
                f32x16 sa;
#pragma unroll
                for (int q = 0; q < 16; ++q) sa[q] = 0.f;
#pragma unroll
                for (int ks = 0; ks < 8; ++ks) {
                    const bf16x8 af = *(const LAS bf16x8*)(K1s + (sb * 32 + r) * 272 + (ks * 16 + 8 * hh) * 2);
                    const bf16x8 bfr = *(const LAS bf16x8*)(Q1s + (tbs * 32 + r) * 272 + (ks * 16 + 8 * hh) * 2);
                    sa = __builtin_amdgcn_mfma_f32_32x32x16_bf16(af, bfr, sa, 0, 0, 0);
                }
                const int t = tbs * 32 + r;
#pragma unroll
                for (int i = 0; i < 4; ++i) { const int s0 = sb * 32 + 8 * i + 4 * hh;
                    const float p0 = (s0 + 0 <= t) ? sa[4 * i + 0] : 0.f, p1 = (s0 + 1 <= t) ? sa[4 * i + 1] : 0.f, p2 = (s0 + 2 <= t) ? sa[4 * i + 2] : 0.f, p3 = (s0 + 3 <= t) ? sa[4 * i + 3] : 0.f;
                    v2u o; o.x = pkbf(p0, p1); o.y = pkbf(p2, p3);
                    *(LAS v2u*)(Ps + t * 144 + s0 * 2) = o; }
            }
#pragma unroll
            for (int ks = 0; ks < 8; ++ks) {
                const bf16x8 af = *(const LAS bf16x8*)(ST + (vb * 32 + r) * 272 + (ks * 16 + 8 * hh) * 2);
                const bf16x8 bfr = *(const LAS bf16x8*)(Q1s + (tb * 32 + r) * 272 + (ks * 16 + 8 * hh) * 2);
                accO = __builtin_amdgcn_mfma_f32_32x32x16_bf16(af, bfr, accO, 0, 0, 0);
            }
            __syncthreads();
            const int nks = (tb + 1) * 2;
            for (int ks = 0; ks < nks; ++ks) {
                const bf16x8 af = *(const LAS bf16x8*)(VT + (vb * 32 + r) * 144 + (ks * 16 + 8 * hh) * 2);
                const bf16x8 bfr = *(const LAS bf16x8*)(Ps + (tb * 32 + r) * 144 + (ks * 16 + 8 * hh) * 2);
                accO = __builtin_amdgcn_mfma_f32_32x32x16_bf16(af, bfr, accO, 0, 0, 0);
            }
        }
        if (!OUT || jc < 3) {
#pragma unroll
            for (int i = 0; i < 4; ++i) { const f32x4 d4 = *(const LAS f32x4*)(dl + kb * 32 + 8 * i + 4 * hh);
#pragma unroll
                for (int x = 0; x < 2; ++x)
#pragma unroll
                    for (int j = 0; j < 4; ++j) S[x][4 * i + j] *= d4[j]; }
#pragma unroll
            for (int ks = 0; ks < 4; ++ks) {
                const bf16x8 af = *(const LAS bf16x8*)(K2T + (kb * 32 + r) * 144 + (ks * 16 + 8 * hh) * 2);
#pragma unroll
                for (int x = 0; x < 2; ++x) {
                    const bf16x8 bfr = *(const LAS bf16x8*)(VT + ((vb0 + x) * 32 + r) * 144 + (ks * 16 + 8 * hh) * 2);
                    S[x] = __builtin_amdgcn_mfma_f32_32x32x16_bf16(af, bfr, S[x], 0, 0, 0);
                }
            }
            if (OUT) {
#pragma unroll
                for (int x = 0; x < 2; ++x)
#pragma unroll
                    for (int i = 0; i < 4; ++i) { v2u o; o.x = pkbf(S[x][4 * i], S[x][4 * i + 1]); o.y = pkbf(S[x][4 * i + 2], S[x][4 * i + 3]);
                        *(LAS v2u*)(ST + ((vb0 + x) * 32 + r) * 272 + (kb * 32 + 8 * i + 4 * hh) * 2) = o; }
            }
        }
        if (OUT) {
            float ssq = 0.f;
#pragma unroll
            for (int q = 0; q < 16; ++q) ssq += accO[q] * accO[q];
            ssq += __shfl_xor(ssq, 32);
            if (hh == 0) ssqb[vb * 64 + tb * 32 + r] = ssq;
        }
        __syncthreads();
        if (OUT) {
            const int tl = tb * 32 + r;
            const float tot = (ssqb[tl] + ssqb[64 + tl]) + (ssqb[128 + tl] + ssqb[192 + tl]);
            const float rs = rsqrtf(tot * (1.0f / 128.0f) + EPS);
#pragma unroll
            for (int i = 0; i < 4; ++i) { const int v0 = vb * 32 + 8 * i + 4 * hh;
                const v2u gw = *(const v2u*)(G + (size_t)(row0 + tl) * 512 + h * 128 + v0); const f32x4 nw = *(const f32x4*)(gbo + h * 128 + v0);
                v2u o; o.x = pkbf(accO[4 * i] * rs * nw[0] * bf_lo(gw.x), accO[4 * i + 1] * rs * nw[1] * bf_hi(gw.x));
                o.y = pkbf(accO[4 * i + 2] * rs * nw[2] * bf_lo(gw.y), accO[4 * i + 3] * rs * nw[3] * bf_hi(gw.y));
                *(v2u*)(Y + (size_t)(row0 + tl) * 1024 + 512 + h * 128 + v0) = o; }
        }
    }
    if (!OUT) {
        float* sl = SLOC + (size_t)(bh * 16 + sc) * 16384;
#pragma unroll
        for (int x = 0; x < 2; ++x)
#pragma unroll
            for (int q = 0; q < 16; ++q) { const int k = kb * 32 + (q & 3) + 8 * (q >> 2) + 4 * hh; sl[(size_t)k * 128 + (vb0 + x) * 32 + r] = S[x][q]; }
        if (part == 0) DTOT[(size_t)(bh * 16 + sc) * 128 + ch] = __expf(btot);
    }
}

#define RLX_AGENT __ATOMIC_RELAXED, __HIP_MEMORY_SCOPE_AGENT
#define XB_TMO      128
#define XB_XCNT(j)  (256  + 64 * (j))
#define XB_XSUB(j)  (1280 + 64 * (j))
#define XB_XGEN(j)  (2304 + 64 * (j))
#define XB_TOP      3328
#define XB_TOPGEN   3392
#define XCD_BAR_WORDS 3456
#define XB_SPIN_CAP (1u << 18)

__device__ __forceinline__ unsigned xb_ld(unsigned* p)              { return __hip_atomic_load(p, __ATOMIC_RELAXED, __HIP_MEMORY_SCOPE_AGENT); }
__device__ __forceinline__ unsigned xb_add(unsigned* p, unsigned v) { return __hip_atomic_fetch_add(p, v, __ATOMIC_RELAXED, __HIP_MEMORY_SCOPE_AGENT); }
__device__ __forceinline__ unsigned xb_xcc_id() { return (unsigned)__builtin_amdgcn_s_getreg((3 << 11) | 20) & 0xFu; }
#define XB_SPIN(cond, bar) do { unsigned _sp = 0; while (cond) { __builtin_amdgcn_s_sleep(1); \
    if ((++_sp & 255u) == 0u) { if (xb_ld(&(bar)[XB_TMO])) break; if (_sp > XB_SPIN_CAP) { atomicAdd(&(bar)[XB_TMO], 1u); break; } } } } while (0)

struct XcdBarrier {
    unsigned* bar; unsigned x;
    volatile LAS unsigned* st;
};

__device__ __forceinline__ XcdBarrier xcd_barrier_post(unsigned* bar, volatile LAS unsigned* st) {
    XcdBarrier b; b.bar = bar; b.x = xb_xcc_id(); b.st = st;
    if (threadIdx.x == 0) (void)xb_add(&bar[XB_XCNT(b.x)], 1u);
    return b;
}
__device__ __forceinline__ void xcd_barrier_complete(unsigned* bar, unsigned x, unsigned& nloc, unsigned& nx) {
    const unsigned G = gridDim.x * gridDim.y * gridDim.z;
    unsigned sum, cnt, mine, sp = 0u;
    for (;;) {
        sum = 0u; cnt = 0u; mine = 0u;
#pragma unroll
        for (unsigned j = 0; j < 16; ++j) { const unsigned c = xb_ld(&bar[XB_XCNT(j)]); sum += c; cnt += (c > 0u) ? 1u : 0u; mine = (j == x) ? c : mine; }
        if (sum == G) break;
        __builtin_amdgcn_s_sleep(1);
        if ((++sp & 255u) == 0u) { if (xb_ld(&bar[XB_TMO])) break; if (sp > XB_SPIN_CAP) { atomicAdd(&bar[XB_TMO], 1u); break; } }
    }
    nloc = mine > 0u ? mine : 1u; nx = cnt > 0u ? cnt : 1u;
}

__device__ __forceinline__ void xcd_barrier(const XcdBarrier& b) {
    asm volatile("s_waitcnt vmcnt(0)" ::: "memory");
    __syncthreads();
    if (threadIdx.x == 0) {
        unsigned* bar = b.bar;
        __builtin_amdgcn_s_waitcnt(0);
        unsigned nloc = b.st[0], nx = b.st[1];
        if (nloc == 0u) { xcd_barrier_complete(bar, b.x, nloc, nx); b.st[0] = nloc; b.st[1] = nx; }
        const unsigned old = xb_add(&bar[XB_XSUB(b.x)], 1u);
        const unsigned gen = old / nloc;
        if (old + 1u == (gen + 1u) * nloc) {
            __builtin_amdgcn_fence(__ATOMIC_RELEASE, "agent");
            asm volatile("s_waitcnt vmcnt(0)" ::: "memory");
            const unsigned og = xb_add(&bar[XB_TOP], 1u);
            const unsigned tg = og / nx;
            if (og + 1u == (tg + 1u) * nx) xb_add(&bar[XB_TOPGEN], 1u);
            else XB_SPIN(xb_ld(&bar[XB_TOPGEN]) == tg, bar);
            __builtin_amdgcn_fence(__ATOMIC_ACQUIRE, "agent");
            xb_add(&bar[XB_XGEN(b.x)], 1u);
            asm volatile("s_waitcnt vmcnt(0)" ::: "memory");
        } else {
            XB_SPIN(xb_ld(&bar[XB_XGEN(b.x)]) == gen, bar);
            __builtin_amdgcn_fence(__ATOMIC_ACQUIRE, "agent");
            asm volatile("s_waitcnt vmcnt(0)" ::: "memory");
        }
    }
    __syncthreads();
}

__global__ void __launch_bounds__(NTHR, 2) fwd_megakernel(Args a) {
    extern __shared__ __attribute__((aligned(16))) unsigned char lds_raw[];
    LAS unsigned char* lds = (LAS unsigned char*)lds_raw;
    cg::grid_group grid = cg::this_grid();
    const int tid = threadIdx.x, G_ = gridDim.x;
    const int lo = a.ph_lo, hi = a.ph_hi;
    unsigned char* ws = a.ws;
#define IN(k) (lo <= (k) && (k) < hi)
#define SEAM(k) do { if (IN(k) && IN((k) + 1)) { for (int rs_ = 0; rs_ < REP_SYNC; ++rs_) { xcd_barrier(bar); } } } while (0)
    volatile LAS unsigned* bst = (volatile LAS unsigned*)(lds + 131072 + 256);
    if (tid < 4) bst[tid] = 0u;
    __syncthreads();
    XcdBarrier bar = xcd_barrier_post((unsigned*)(ws + WS_BAR), bst);
    if (a.ph_lo < 0) grid.sync();
    float* rowss = (float*)(ws + WS_SS);
    bf16* XB = (bf16*)(ws + WS_XB); bf16* HB = (bf16*)(ws + WS_H);
    bf16* Ub = (bf16*)(ws + WS_U); bf16* Vb = (bf16*)(ws + WS_V); bf16* Qb = (bf16*)(ws + WS_Q); float* LFb = (float*)(ws + WS_LF); bf16* Ib = (bf16*)(ws + WS_I); bf16* Gb = (bf16*)(ws + WS_G);
    bf16* Yb = (bf16*)(ws + WS_Y); float* SLOC = (float*)(ws + WS_SLOC); float* DTOT = (float*)(ws + WS_DTOT);

#ifndef SKIP_P0
    if (IN(0)) { for (int rp_ = 0; rp_ < REP_P0; ++rp_) { p0_prologue(a, lds, tid); __syncthreads(); } }
#endif
    SEAM(0);
    for (int l = 0; l < 2; ++l) {
        const int p = 1 + 6 * l;
        unsigned char* wl = ws + WS_W + (size_t)l * W_LAYER;
#ifndef SKIP_G1
        if (IN(p)) for (int rg_ = 0; rg_ < REP_G13; ++rg_) {
            pg8::Gemm g{XB, (const bf16*)(wl + W_IN), M, DIN, D}; pg8::StaticOrder S; S.init(M, DIN, G_, (int)blockIdx.x);
            pg8::EpiIn E{rowss + (size_t)(2 * l) * M, (const float*)(ws + WS_LB) + l * 512, Ub, Vb, Qb, LFb, Ib, Gb};
            pg8::gemm_phase<pg8::EpiIn, pg8::StaticOrder, true, true>(lds, g, S, E);
        }
#endif
        SEAM(p);
#ifndef SKIP_MIX1
        if (IN(p + 1)) for (int rm_ = 0; rm_ < REP_MIX; ++rm_) {
            for (int it = blockIdx.x; it < 256; it += G_)
                hgrn_item<false>(lds, it, Qb, LFb, Ib, Gb, a.in[8] + l * 512, SLOC, DTOT, Yb, tid);
            int gl = -1;
            for (int it = blockIdx.x; it < 512; it += G_) {
                if ((it & 3) != gl) { gl = it & 3; gmlp_stage_w(lds, a.in[3] + (size_t)l * 4 * 128 * 128, gl, tid); }
                gmlp_item(lds, it, Ub, Vb, a.in[3] + (size_t)l * 4 * 128 * 128, a.in[4] + l * 512, a.in[5] + l * 512, a.in[6] + l * 512, Yb, tid);
            }
            __syncthreads();
        }
#endif
        SEAM(p + 1);
#ifndef SKIP_MIX2
        if (IN(p + 2)) for (int rm_ = 0; rm_ < REP_MIX; ++rm_) {
            for (int it = blockIdx.x; it < 256; it += G_)
                hgrn_item<true>(lds, it, Qb, LFb, Ib, Gb, a.in[8] + l * 512, SLOC, DTOT, Yb, tid);
            __syncthreads();
        }
#endif
        SEAM(p + 2);
#ifndef SKIP_G2
        if (IN(p + 3)) {
            pg8::Gemm g{Yb, (const bf16*)(wl + W_OUT), M, D, D}; pg8::StaticOrder S; S.init(M, D, G_, (int)blockIdx.x);
            pg8::EpiRes E{l == 0 ? a.in[0] : a.out, a.out, XB, rowss + (size_t)(2 * l + 1) * M};
            pg8::gemm_phase<pg8::EpiRes, pg8::StaticOrder, false, true>(lds, g, S, E);
        }
#endif
        SEAM(p + 3);
#ifndef SKIP_G3
        if (IN(p + 4)) for (int rg_ = 0; rg_ < REP_G13; ++rg_) {
            pg8::Gemm g{XB, (const bf16*)(wl + W_UP), M, DFF, D}; pg8::StaticOrder S; S.init(M, DFF, G_, (int)blockIdx.x);
            pg8::EpiSq E{rowss + (size_t)(2 * l + 1) * M, HB, DFF};
            pg8::gemm_phase<pg8::EpiSq, pg8::StaticOrder, true, true>(lds, g, S, E);
        }
#endif
        SEAM(p + 4);
#ifndef SKIP_G4
        if (IN(p + 5)) {
            pg8::Gemm g{HB, (const bf16*)(wl + W_DOWN), M, D, DFF}; pg8::StaticOrder S; S.init(M, D, G_, (int)blockIdx.x);
            pg8::EpiRes E{a.out, a.out, XB, rowss + (size_t)(2 * l + 2) * M};
            pg8::gemm_phase<pg8::EpiRes, pg8::StaticOrder, false, true>(lds, g, S, E);
        }
#endif
        SEAM(p + 5);
    }
    if (IN(13)) {
        const int lane = tid & 63, wave = tid >> 6; const float* ssf = rowss + (size_t)4 * M; const f32x4* nf = (const f32x4*)a.in[13] + lane;
        for (int m = blockIdx.x * NWAVES + wave; m < M; m += G_ * NWAVES) {
            const float rs = rsqrtf(ssf[m] * (1.0f / 1024.0f) + EPS);
            f32x4* xr = (f32x4*)(a.out + (size_t)m * D) + lane;
#pragma unroll
            for (int j = 0; j < 4; ++j) { const f32x4 v = xr[64 * j]; xr[64 * j] = v * rs * nf[64 * j]; }
        }
    }
#undef IN
#undef SEAM
}

extern "C" void kernel_launch(void* const* d_in, const int* in_sizes, int n_in, void* d_out, int out_size, void* d_ws, size_t ws_size, hipStream_t stream) {
    static int grid = 0;
    if (grid == 0) {
        if (n_in != 14 || in_sizes[0] != M * D || out_size != M * D || ws_size < WS_END) { fprintf(stderr, "kernel_launch: unexpected shapes (n_in %d, in0 %d, out %d, ws %zu)\n", n_in, n_in > 0 ? in_sizes[0] : -1, out_size, ws_size); grid = -1; return; }
        int dev = 0, cus = 0, per_cu = 0;
        if (hipGetDevice(&dev) != hipSuccess || hipDeviceGetAttribute(&cus, hipDeviceAttributeMultiprocessorCount, dev) != hipSuccess) { grid = -1; return; }
        if (hipFuncSetAttribute((const void*)fwd_megakernel, hipFuncAttributeMaxDynamicSharedMemorySize, LDS_BYTES) != hipSuccess) { fprintf(stderr, "kernel_launch: hipFuncSetAttribute failed\n"); grid = -1; return; }
        if (hipOccupancyMaxActiveBlocksPerMultiprocessor(&per_cu, (const void*)fwd_megakernel, NTHR, LDS_BYTES) != hipSuccess || per_cu < 1) { fprintf(stderr, "kernel_launch: occupancy query reports %d blocks per CU\n", per_cu); (void)hipGetLastError(); grid = -1; return; }
        grid = cus;
    }
    if (grid < 0) return;
    (void)hipMemsetAsync((char*)d_ws + WS_SS, 0, CTL_ZERO_BYTES, stream);
    Args a{};
    for (int i = 0; i < 14; ++i) a.in[i] = (const float*)d_in[i];
    a.out = (float*)d_out; a.ws = (unsigned char*)d_ws;
#if MK_N_LAUNCHES == 1
    a.ph_lo = 0; a.ph_hi = NPHASE;
    void* args[] = {&a};
    hipError_t e = hipLaunchCooperativeKernel((const void*)fwd_megakernel, dim3(grid), dim3(NTHR), args, LDS_BYTES, stream);
    if (e != hipSuccess) fprintf(stderr, "kernel_launch: cooperative launch failed: %s (grid %d)\n", hipGetErrorString(e), grid);
#else
    for (int ph = 0; ph < NPHASE; ++ph) { a.ph_lo = ph; a.ph_hi = ph + 1; hipLaunchKernelGGL(fwd_megakernel, dim3(grid), dim3(NTHR), LDS_BYTES, stream, a); }
#endif
}
```

```cpp
#include <hip/hip_runtime.h>
#include <hip/hip_cooperative_groups.h>
#include <cstdio>
#include <cstdint>
namespace cg = cooperative_groups;
namespace pg8 {
#define PG8_LAS __attribute__((address_space(3)))
typedef unsigned short bf16_t;
typedef short bf16x8 __attribute__((ext_vector_type(8)));
typedef float f32x4 __attribute__((ext_vector_type(4)));
typedef unsigned u32x4 __attribute__((ext_vector_type(4)));
constexpr int BM = 256, BK = 64, HALF = 128, HTB = HALF * BK * 2  , STAGE_BYTES = 8 * HTB, NXCD = 8, WGM = 8;

__host__ __device__ __forceinline__ int lds_byte(int r, int c) { const int st = (r >> 4) * 2 + (c >> 5), rr = r & 15, cc = c & 31, ob = rr * 64 + cc * 2; return st * 1024 + (ob ^ (((ob >> 9) & 1) << 5)); }
__host__ __device__ __forceinline__ void stage_rc(int b, int& R, int& C) { const int st = b / 1024, sb = b % 1024, swz = sb ^ (((sb >> 9) & 1) << 5); R = (st >> 1) * 16 + swz / 64; C = (st & 1) * 32 + (swz % 64) / 2; }
__host__ __device__ __forceinline__ int perm32(int rho) { const int n = rho >> 4, i = rho & 15; return 8 * (i >> 2) + 4 * n + (i & 3); }

struct Unit { int pm, pn; };
struct Gemm { const bf16_t* A; const bf16_t* Bt; int M, N, K; };

struct StaticOrder {
    int nM, nN, nwg, G, c;
    __host__ __device__ void init(int M, int N, int G_, int c_) { nM = M / BM; nN = N / BM; nwg = nM * nN; G = G_; c = c_; }
    __host__ __device__ bool next(int i, Unit& u) const {
        const long L = (long)i * G + c; if (L >= nwg) return false;
        int wgid = (int)L; { const int q = nwg / NXCD, r = nwg % NXCD, xcd = wgid % NXCD, off = wgid / NXCD; wgid = (xcd < r ? xcd * (q + 1) : r * (q + 1) + (xcd - r) * q) + off; }
        const int nig = WGM * nN, gid = wgid / nig, fm = gid * WGM, gsz = (nM - fm) < WGM ? (nM - fm) : WGM;
        u.pm = fm + ((wgid % nig) % gsz); u.pn = (wgid % nig) / gsz; return true;
    }
    __device__ __forceinline__ void a_ready(const Unit&) const {}
    __device__ __forceinline__ void done(const Unit&) const {}
};


__device__ __forceinline__ unsigned cvt_pk_bf16(float lo, float hi) { unsigned r; asm volatile("v_cvt_pk_bf16_f32 %0, %1, %2" : "=v"(r) : "v"(lo), "v"(hi)); return r; }
__device__ __forceinline__ float sigmoidf_fast(float z) { return __builtin_amdgcn_rcpf(1.0f + __expf(-z)); }
__device__ __forceinline__ float gelu_tanh(float x) { const float t = 1.5957691216057308f * (x + 0.044715f * x * x * x); return x * sigmoidf_fast(t); }

struct EpiIn {
    static constexpr bool PERM = true, AFTER_DRAIN = false;
    const float* rowss; const float* lb; bf16_t* U; bf16_t* V; bf16_t* Q; float* LF; bf16_t* I; bf16_t* G;
    __device__ __forceinline__ void operator()(const f32x4 (&acc)[2][2][4][2], const Unit& u, int wr, int wc, int fr, int fq) const {
        const int type = u.pn >> 1;
        const int row0 = u.pm * BM + wr * 64 + fr, cs = (u.pn & 1) * 256 + wc * 32 + 8 * fq;
        float rr[2][4];
#pragma unroll
        for (int ai = 0; ai < 2; ++ai)
#pragma unroll
            for (int m = 0; m < 4; ++m) rr[ai][m] = rowss[row0 + ai * HALF + m * 16];
#pragma unroll
        for (int ai = 0; ai < 2; ++ai)
#pragma unroll
            for (int m = 0; m < 4; ++m) rr[ai][m] = rsqrtf(rr[ai][m] * (1.0f / 1024.0f) + 1e-6f);
        if (type == 3) {
            f32x4 l0[2], l1[2];
#pragma unroll
            for (int bj = 0; bj < 2; ++bj) { l0[bj] = *(const f32x4*)(lb + cs + bj * HALF); l1[bj] = *(const f32x4*)(lb + cs + bj * HALF + 4); }
#pragma unroll
            for (int ai = 0; ai < 2; ++ai)
#pragma unroll
                for (int m = 0; m < 4; ++m) { const int row = row0 + ai * HALF + m * 16; const float r = rr[ai][m];
#pragma unroll
                    for (int bj = 0; bj < 2; ++bj) { f32x4 v0 = acc[ai][bj][m][0] * r, v1 = acc[ai][bj][m][1] * r;
#pragma unroll
                        for (int j = 0; j < 4; ++j) { v0[j] = __logf(l0[bj][j] + (1.0f - l0[bj][j]) * sigmoidf_fast(v0[j])); v1[j] = __logf(l1[bj][j] + (1.0f - l1[bj][j]) * sigmoidf_fast(v1[j])); }
                        float* p = LF + (size_t)row * 512 + cs + bj * HALF; *(f32x4*)p = v0; *(f32x4*)(p + 4) = v1; } }
        } else {
            bf16_t* ob = type == 0 ? U : type == 1 ? V : type == 2 ? Q : type == 4 ? I : G;
#pragma unroll
            for (int ai = 0; ai < 2; ++ai)
#pragma unroll
                for (int m = 0; m < 4; ++m) { const int row = row0 + ai * HALF + m * 16; const float r = rr[ai][m];
#pragma unroll
                    for (int bj = 0; bj < 2; ++bj) { f32x4 v0 = acc[ai][bj][m][0] * r, v1 = acc[ai][bj][m][1] * r;
                        if (type <= 1) {
#pragma unroll
                            for (int j = 0; j < 4; ++j) { v0[j] = gelu_tanh(v0[j]); v1[j] = gelu_tanh(v1[j]); } }
                        else if (type == 5) {
#pragma unroll
                            for (int j = 0; j < 4; ++j) { v0[j] = v0[j] * sigmoidf_fast(v0[j]); v1[j] = v1[j] * sigmoidf_fast(v1[j]); } }
                        u32x4 w; w.x = cvt_pk_bf16(v0[0], v0[1]); w.y = cvt_pk_bf16(v0[2], v0[3]); w.z = cvt_pk_bf16(v1[0], v1[1]); w.w = cvt_pk_bf16(v1[2], v1[3]);
                        *(u32x4*)(ob + (size_t)row * 512 + cs + bj * HALF) = w; } }
        }
    }
};
struct EpiSq {
    static constexpr bool PERM = true, AFTER_DRAIN = false;
    const float* rowss; bf16_t* O; int ldc;
    __device__ __forceinline__ void operator()(const f32x4 (&acc)[2][2][4][2], const Unit& u, int wr, int wc, int fr, int fq) const {
        const int row0 = u.pm * BM + wr * 64 + fr, col0 = u.pn * BM + wc * 32 + 8 * fq;
        float rr[2][4];
#pragma unroll
        for (int ai = 0; ai < 2; ++ai)
#pragma unroll
            for (int m = 0; m < 4; ++m) rr[ai][m] = rowss[row0 + ai * HALF + m * 16];
#pragma unroll
        for (int ai = 0; ai < 2; ++ai)
#pragma unroll
            for (int m = 0; m < 4; ++m) rr[ai][m] = rsqrtf(rr[ai][m] * (1.0f / 1024.0f) + 1e-6f);
#pragma unroll
        for (int ai = 0; ai < 2; ++ai)
#pragma unroll
            for (int m = 0; m < 4; ++m) { const int row = row0 + ai * HALF + m * 16; const float r = rr[ai][m];
#pragma unroll
                for (int bj = 0; bj < 2; ++bj) { f32x4 v0 = acc[ai][bj][m][0] * r, v1 = acc[ai][bj][m][1] * r;
#pragma unroll
                    for (int j = 0; j < 4; ++j) { const float a = fmaxf(v0[j], 0.f), b = fmaxf(v1[j], 0.f); v0[j] = a * a; v1[j] = b * b; }
                    u32x4 w; w.x = cvt_pk_bf16(v0[0], v0[1]); w.y = cvt_pk_bf16(v0[2], v0[3]); w.z = cvt_pk_bf16(v1[0], v1[1]); w.w = cvt_pk_bf16(v1[2], v1[3]);
                    *(u32x4*)(O + (size_t)row * ldc + col0 + bj * HALF) = w; } }
    }
};
struct EpiRes {
    static constexpr bool PERM = true, AFTER_DRAIN = false;
    const float* xin; float* xout; bf16_t* xb; float* ss_out;
    __device__ __forceinline__ void operator()(const f32x4 (&acc)[2][2][4][2], const Unit& u, int wr, int wc, int fr, int fq) const {
        const int row0 = u.pm * BM + wr * 64 + fr, col0 = u.pn * BM + wc * 32 + 8 * fq;
#pragma unroll
        for (int ai = 0; ai < 2; ++ai) {
            f32x4 xa[4][2][2];
#pragma unroll
            for (int m = 0; m < 4; ++m)
#pragma unroll
                for (int bj = 0; bj < 2; ++bj) { const size_t off = (size_t)(row0 + ai * HALF + m * 16) * 1024 + col0 + bj * HALF;
                    xa[m][bj][0] = *(const f32x4*)(xin + off); xa[m][bj][1] = *(const f32x4*)(xin + off + 4); }
            asm volatile("" ::: "memory");
#pragma unroll
            for (int m = 0; m < 4; ++m) { const int row = row0 + ai * HALF + m * 16; float ss = 0.f;
#pragma unroll
                for (int bj = 0; bj < 2; ++bj) { const size_t off = (size_t)row * 1024 + col0 + bj * HALF;
                    const f32x4 o0 = xa[m][bj][0] + acc[ai][bj][m][0], o1 = xa[m][bj][1] + acc[ai][bj][m][1];
                    *(f32x4*)(xout + off) = o0; *(f32x4*)(xout + off + 4) = o1;
                    u32x4 w; w.x = cvt_pk_bf16(o0[0], o0[1]); w.y = cvt_pk_bf16(o0[2], o0[3]); w.z = cvt_pk_bf16(o1[0], o1[1]); w.w = cvt_pk_bf16(o1[2], o1[3]);
                    *(u32x4*)(xb + off) = w;
                    ss += (o0[0] * o0[0] + o0[1] * o0[1]) + (o0[2] * o0[2] + o0[3] * o0[3]) + (o1[0] * o1[0] + o1[1] * o1[1]) + (o1[2] * o1[2] + o1[3] * o1[3]); }
                ss += __shfl_xor(ss, 16); ss += __shfl_xor(ss, 32);
                if (fq == 0) atomicAdd(ss_out + row, ss); }
            asm volatile("" ::: "memory");
        }
    }
};

template <class Epi, class Sched, bool ALIGN_EPI = false, bool SP2 = false>
__device__ __forceinline__ void gemm_phase(PG8_LAS unsigned char* lds, const Gemm g, const Sched& S, const Epi& E) {
    int tid_ = threadIdx.x; asm volatile("" : "+v"(tid_));
    const int tid = tid_, wid = __builtin_amdgcn_readfirstlane(tid >> 6), lane = tid & 63, wr = wid >> 2, wc = wid & 3, fr = lane & 15, fq = lane >> 4;
    const int K = g.K, nt = K / BK;
    unsigned voffA[2], voffB[2];
#pragma unroll
    for (int i = 0; i < 2; ++i) { int R, C; stage_rc(tid * 16 + i * 8192, R, C); const int Rb = Epi::PERM ? ((R & ~31) + perm32(R & 31)) : R;
        voffA[i] = (unsigned)(R * K + C) * 2u; voffB[i] = (unsigned)(Rb * K + C) * 2u; }
    const size_t kstep = (size_t)(BK * 2);
    const size_t hstep = (size_t)HALF * K * 2;
    const size_t tstep = 2 * hstep;
    const unsigned ldsw = (unsigned)wid * 1024u;
    const int aoff = lds_byte(wr * 64 + fr, fq * 8), boff = lds_byte(wc * 32 + fr, fq * 8);
#define PG8_SA(b, h) (((b) * 2 + (h)) * HTB)
#define PG8_SB(b, h) ((4 + (b) * 2 + (h)) * HTB)
#define PG8_STAGE(bufoff, gbase, voff) do { _Pragma("unroll") for (int _i = 0; _i < 2; ++_i) \
        __builtin_amdgcn_global_load_lds((const unsigned*)((const char*)(gbase) + (voff)[_i]), (PG8_LAS unsigned*)(lds + (bufoff) + ldsw + _i * 8192), 16, 0, 0); } while (0)
#define PG8_LDA(dst, b, h) do { _Pragma("unroll") for (int m = 0; m < 4; ++m) _Pragma("unroll") for (int k = 0; k < 2; ++k) dst[m][k] = *(const PG8_LAS bf16x8*)(lds + PG8_SA(b, h) + aoff + m * 2048 + k * 1024); } while (0)
#define PG8_LDB(dst, b, h) do { _Pragma("unroll") for (int n = 0; n < 2; ++n) _Pragma("unroll") for (int k = 0; k < 2; ++k) dst[n][k] = *(const PG8_LAS bf16x8*)(lds + PG8_SB(b, h) + boff + n * 2048 + k * 1024); } while (0)
#define PG8_MMA(ai, bj, At, Bt) do { __builtin_amdgcn_s_setprio(1); _Pragma("unroll") for (int m = 0; m < 4; ++m) _Pragma("unroll") for (int n = 0; n < 2; ++n) _Pragma("unroll") for (int k = 0; k < 2; ++k) \
        acc[ai][bj][m][n] = __builtin_amdgcn_mfma_f32_16x16x32_bf16(Bt[n][k], At[m][k], acc[ai][bj][m][n], 0, 0, 0); __builtin_amdgcn_s_setprio(0); } while (0)
#define PG8_WAIT_V(n) asm volatile("s_waitcnt vmcnt(" #n ")" ::: "memory")
#define PG8_WAIT_L(n) asm volatile("s_waitcnt lgkmcnt(" #n ")" ::: "memory")
#define PG8_BAR __builtin_amdgcn_s_barrier()
#define PG8_SCHED __builtin_amdgcn_sched_barrier(0)
    Unit cur, nxt; int ui = 0;
    if (!S.next(0, cur)) return;
    f32x4 acc[2][2][4][2];
#pragma unroll
    for (int a = 0; a < 2; ++a)
#pragma unroll
        for (int b = 0; b < 2; ++b)
#pragma unroll
            for (int m = 0; m < 4; ++m)
#pragma unroll
                for (int n = 0; n < 2; ++n) acc[a][b][m][n] = (f32x4){0.f, 0.f, 0.f, 0.f};
    bf16x8 At[4][2], B0[2][2], B1[2][2];
    const char* cA = (const char*)g.A + (size_t)cur.pm * tstep; const char* cB = (const char*)g.Bt + (size_t)cur.pn * tstep;
    S.a_ready(cur);
    if constexpr (SP2) {
        PG8_STAGE(PG8_SB(0, 0), cB, voffB); PG8_STAGE(PG8_SB(0, 1), cB + hstep, voffB); PG8_STAGE(PG8_SA(0, 0), cA, voffA); PG8_STAGE(PG8_SA(0, 1), cA + hstep, voffA);
        if (wr == 1) PG8_BAR;
        PG8_WAIT_V(2); PG8_BAR;
        PG8_STAGE(PG8_SB(1, 0), cB + kstep, voffB); PG8_STAGE(PG8_SA(1, 0), cA + kstep, voffA); PG8_STAGE(PG8_SB(1, 1), cB + hstep + kstep, voffB);
        PG8_WAIT_V(6); PG8_BAR;
    } else {
        PG8_STAGE(PG8_SB(0, 0), cB, voffB); PG8_STAGE(PG8_SA(0, 0), cA, voffA); PG8_STAGE(PG8_SB(0, 1), cB + hstep, voffB); PG8_STAGE(PG8_SA(0, 1), cA + hstep, voffA);
        if (wr == 1) PG8_BAR;
        PG8_WAIT_V(4); PG8_BAR;
        PG8_STAGE(PG8_SB(1, 0), cB + kstep, voffB); PG8_STAGE(PG8_SA(1, 0), cA + kstep, voffA); PG8_STAGE(PG8_SB(1, 1), cB + hstep + kstep, voffB);
        PG8_WAIT_V(6); PG8_BAR;
    }
    for (;;) {
        const bool has_next = S.next(ui + 1, nxt);
        const char* nA = has_next ? (const char*)g.A + (size_t)nxt.pm * tstep : cA; const char* nB = has_next ? (const char*)g.Bt + (size_t)nxt.pn * tstep : cB;
        for (int t = 0; t < nt; t += 2) {
            const bool last = (t == nt - 2);
            const char* a1 = cA + (size_t)(t + 1) * kstep;
            const char* a2 = last ? nA : cA + (size_t)(t + 2) * kstep; const char* b2 = last ? nB : cB + (size_t)(t + 2) * kstep;
            const char* a3 = a2 + kstep; const char* b3 = b2 + kstep;
            if (last && has_next) S.a_ready(nxt);
            if constexpr (SP2) {
            PG8_LDB(B0, 0, 0); PG8_LDB(B1, 0, 1); PG8_SCHED; PG8_LDA(At, 0, 0); PG8_STAGE(PG8_SA(1, 1), a1 + hstep, voffA);
            PG8_WAIT_V(8); PG8_WAIT_L(0); PG8_BAR; PG8_MMA(0, 0, At, B0); PG8_MMA(0, 1, At, B1); PG8_BAR; PG8_SCHED;
            PG8_LDA(At, 0, 1); PG8_STAGE(PG8_SB(0, 0), b2, voffB); PG8_STAGE(PG8_SB(0, 1), b2 + hstep, voffB); PG8_STAGE(PG8_SA(0, 0), a2, voffA);
            PG8_WAIT_V(8); PG8_WAIT_L(0); PG8_BAR; PG8_MMA(1, 0, At, B0); PG8_MMA(1, 1, At, B1); PG8_BAR; PG8_SCHED;
            PG8_LDB(B0, 1, 0); PG8_LDB(B1, 1, 1); PG8_SCHED; PG8_LDA(At, 1, 0); PG8_STAGE(PG8_SA(0, 1), a2 + hstep, voffA);
            PG8_WAIT_V(8); PG8_WAIT_L(0); PG8_BAR; PG8_MMA(0, 0, At, B0); PG8_MMA(0, 1, At, B1); PG8_BAR; PG8_SCHED;
            PG8_LDA(At, 1, 1); PG8_STAGE(PG8_SB(1, 0), b3, voffB); PG8_STAGE(PG8_SB(1, 1), b3 + hstep, voffB); PG8_STAGE(PG8_SA(1, 0), a3, voffA);
            PG8_WAIT_V(8); PG8_WAIT_L(0); PG8_BAR; PG8_MMA(1, 0, At, B0); PG8_MMA(1, 1, At, B1); PG8_BAR; PG8_SCHED;
            } else {
            PG8_LDB(B0, 0, 0); PG8_SCHED; PG8_LDA(At, 0, 0); PG8_STAGE(PG8_SA(1, 1), a1 + hstep, voffA);
            PG8_WAIT_L(8); PG8_BAR; PG8_WAIT_L(0); PG8_MMA(0, 0, At, B0); PG8_BAR; PG8_SCHED;
            PG8_LDB(B1, 0, 1); PG8_STAGE(PG8_SB(0, 0), b2, voffB);
            PG8_BAR; PG8_WAIT_L(0); PG8_MMA(0, 1, At, B1); PG8_BAR;
            PG8_LDA(At, 0, 1); PG8_STAGE(PG8_SA(0, 0), a2, voffA);
            PG8_BAR; PG8_WAIT_L(0); PG8_MMA(1, 0, At, B0); PG8_BAR; PG8_SCHED;
            PG8_STAGE(PG8_SB(0, 1), b2 + hstep, voffB);
            PG8_WAIT_V(6); PG8_BAR; PG8_MMA(1, 1, At, B1); PG8_BAR;
            PG8_LDB(B0, 1, 0); PG8_SCHED; PG8_LDA(At, 1, 0); PG8_STAGE(PG8_SA(0, 1), a2 + hstep, voffA);
            PG8_WAIT_L(8); PG8_BAR; PG8_WAIT_L(0); PG8_MMA(0, 0, At, B0); PG8_BAR; PG8_SCHED;
            PG8_LDB(B1, 1, 1); PG8_STAGE(PG8_SB(1, 0), b3, voffB);
            PG8_BAR; PG8_WAIT_L(0); PG8_MMA(0, 1, At, B1); PG8_BAR;
            PG8_LDA(At, 1, 1); PG8_STAGE(PG8_SA(1, 0), a3, voffA);
            PG8_BAR; PG8_WAIT_L(0); PG8_MMA(1, 0, At, B0); PG8_BAR; PG8_SCHED;
            PG8_STAGE(PG8_SB(1, 1), b3 + hstep, voffB);
            PG8_WAIT_V(6); PG8_BAR; PG8_MMA(1, 1, At, B1); PG8_BAR;
            }
        }
        if constexpr (ALIGN_EPI) { if (wr == 0) PG8_BAR; }
        if constexpr (!Epi::AFTER_DRAIN) { E(acc, cur, wr, wc, fr, fq); S.done(cur); }
        if (!has_next) break;
#pragma unroll
        for (int a = 0; a < 2; ++a)
#pragma unroll
            for (int b = 0; b < 2; ++b)
#pragma unroll
                for (int m = 0; m < 4; ++m)
#pragma unroll
                    for (int n = 0; n < 2; ++n) acc[a][b][m][n] = (f32x4){0.f, 0.f, 0.f, 0.f};
        cur = nxt; cA = nA; cB = nB; ++ui;
        if constexpr (ALIGN_EPI) { if (wr == 1) PG8_BAR; }
    }
    PG8_WAIT_V(0);
    if constexpr (!ALIGN_EPI) { if (wr == 0) PG8_BAR; }
    PG8_BAR;
    if constexpr (Epi::AFTER_DRAIN) { E.fused(acc, cur, wr, wc, fr, fq, lds, wid, lane); S.done(cur); }
#undef PG8_SA
#undef PG8_SB
#undef PG8_STAGE
#undef PG8_LDA
#undef PG8_LDB
#undef PG8_MMA
#undef PG8_WAIT_V
#undef PG8_WAIT_L
#undef PG8_BAR
#undef PG8_SCHED
}
}

#ifndef MK_N_LAUNCHES
#define MK_N_LAUNCHES 1
#endif
#ifndef REP_MIX
#define REP_MIX 1
#endif
#ifndef REP_G13
#define REP_G13 1
#endif
#ifndef REP_SYNC
#define REP_SYNC 1
#endif
#ifndef REP_P0
#define REP_P0 1
#endif
constexpr int NWAVES = 8, NTHR = 512;
constexpr int M = 16384, D = 1024, DIN = 3072, DFF = 4096, SEQ = 4096;
constexpr int NPHASE = 14;
constexpr float EPS = 1e-6f;
constexpr size_t MiB = 1u << 20;
constexpr size_t WS_SS = 0, SS_BYTES = 5 * (size_t)M * 4;
constexpr size_t WS_BAR = 384 * 1024;
constexpr size_t CTL_ZERO_BYTES = 448 * 1024;
constexpr size_t WS_LB = 512 * 1024;
constexpr size_t WS_W = 1 * MiB, W_LAYER = 24 * MiB, W_IN = 0, W_OUT = 6 * MiB, W_UP = 8 * MiB, W_DOWN = 16 * MiB;
constexpr size_t WS_XB = 49 * MiB;
constexpr size_t WS_H = 81 * MiB;
constexpr size_t WS_U = 81 * MiB, WS_V = 97 * MiB, WS_Q = 113 * MiB, WS_LF = 129 * MiB, WS_I = 161 * MiB, WS_G = 177 * MiB, WS_Y = 193 * MiB, WS_SLOC = 225 * MiB, WS_DTOT = 241 * MiB;
constexpr size_t WS_END = 242 * MiB;
constexpr int LDS_BYTES = 147456;

#define LAS __attribute__((address_space(3)))
typedef unsigned short bf16;
typedef unsigned v4u __attribute__((ext_vector_type(4)));
typedef unsigned v2u __attribute__((ext_vector_type(2)));
typedef float f32x4 __attribute__((ext_vector_type(4)));
typedef float f32x16 __attribute__((ext_vector_type(16)));
typedef short bf16x8 __attribute__((ext_vector_type(8)));
#define LDS_WAIT() asm volatile("s_waitcnt lgkmcnt(0)" ::: "memory")
__device__ __forceinline__ unsigned pkbf(float lo, float hi) { return pg8::cvt_pk_bf16(lo, hi); }
__device__ __forceinline__ float bf_lo(unsigned w) { return __uint_as_float(w << 16); }
__device__ __forceinline__ float bf_hi(unsigned w) { return __uint_as_float(w & 0xffff0000u); }
__device__ __forceinline__ float bf1(bf16 v) { return __uint_as_float(((unsigned)v) << 16); }
__device__ __forceinline__ bf16 tobf(float f) { return (bf16)(pg8::cvt_pk_bf16(f, 0.f) & 0xffffu); }
__device__ __forceinline__ float wave_sum(float v) {
#pragma unroll
    for (int o = 1; o < 64; o <<= 1) v += __shfl_xor(v, o);
    return v;
}

__device__ __forceinline__ void p0_transpose_item(const float* W, int K, int N, bf16* WT, const float* ksc, LAS float* scr, int item, int lane) {
    const int nblk = N / 32, kb = item / nblk, nb = item % nblk, k0 = 64 * kb, n0 = 32 * nb;
    const int kr = lane >> 3, n4 = (lane & 7) * 4;
    f32x4 v[8];
#pragma unroll
    for (int i = 0; i < 8; ++i) v[i] = *(const f32x4*)(W + (size_t)(k0 + 8 * i + kr) * N + n0 + n4);
#pragma unroll
    for (int i = 0; i < 8; ++i) { const int kk = 8 * i + kr; const float s = ksc ? ksc[k0 + kk] : 1.0f; LAS float* d = scr + kk * 33 + n4;
        d[0] = v[i].x * s; d[1] = v[i].y * s; d[2] = v[i].z * s; d[3] = v[i].w * s; }
    LDS_WAIT(); asm volatile("" ::: "memory");
    const int c = lane & 7;
#pragma unroll
    for (int j = 0; j < 4; ++j) { const int n = (lane >> 3) + 8 * j; const LAS float* sp = scr + (8 * c) * 33 + n;
        v4u o; o.x = pkbf(sp[0 * 33], sp[1 * 33]); o.y = pkbf(sp[2 * 33], sp[3 * 33]); o.z = pkbf(sp[4 * 33], sp[5 * 33]); o.w = pkbf(sp[6 * 33], sp[7 * 33]);
        *(v4u*)(WT + (size_t)(n0 + n) * K + k0 + 8 * c) = o; }
    LDS_WAIT(); asm volatile("" ::: "memory");
}

struct Args { const float* in[14]; float* out; unsigned char* ws; int ph_lo, ph_hi; };

__device__ __forceinline__ void p0_prologue(const Args& a, LAS unsigned char* lds, int tid_) {
    int tid = tid_; asm volatile("" : "+v"(tid));
    const int lane = tid & 63, wave = tid >> 6;
    LAS float* scr = (LAS float*)(lds + wave * 16384);
    const int gw = blockIdx.x * NWAVES + wave, NGW = gridDim.x * NWAVES;
    constexpr int I_IN = (D / 64) * (DIN / 32), I_OUT = (D / 64) * (D / 32), I_UP = (D / 64) * (DFF / 32), I_DN = (DFF / 64) * (D / 32), I_L = I_IN + I_OUT + I_UP + I_DN;
    for (int it = gw; it < 2 * I_L; it += NGW) {
        const int l = it / I_L; int r = it % I_L;
        unsigned char* wl = a.ws + WS_W + (size_t)l * W_LAYER;
        if (r < I_IN) { p0_transpose_item(a.in[2] + (size_t)l * D * DIN, D, DIN, (bf16*)(wl + W_IN), a.in[1] + l * D, scr, r, lane); continue; } r -= I_IN;
        if (r < I_OUT) { p0_transpose_item(a.in[9] + (size_t)l * D * D, D, D, (bf16*)(wl + W_OUT), nullptr, scr, r, lane); continue; } r -= I_OUT;
        if (r < I_UP) { p0_transpose_item(a.in[11] + (size_t)l * D * DFF, D, DFF, (bf16*)(wl + W_UP), a.in[10] + l * D, scr, r, lane); continue; } r -= I_UP;
        p0_transpose_item(a.in[12] + (size_t)l * DFF * D, DFF, D, (bf16*)(wl + W_DOWN), nullptr, scr, r, lane);
    }
    bf16* XB = (bf16*)(a.ws + WS_XB); float* ss0 = (float*)(a.ws + WS_SS);
    for (int m = gw; m < M; m += NGW) {
        const f32x4* xr = (const f32x4*)(a.in[0] + (size_t)m * D) + lane; float s = 0.f;
        unsigned long long* o8 = (unsigned long long*)(XB + (size_t)m * D) + lane;
#pragma unroll
        for (int j = 0; j < 4; ++j) { const f32x4 v = xr[64 * j]; s += (v.x * v.x + v.y * v.y) + (v.z * v.z + v.w * v.w);
            o8[64 * j] = (unsigned long long)pkbf(v.x, v.y) | ((unsigned long long)pkbf(v.z, v.w) << 32); }
        s = wave_sum(s);
        if (lane == 0) ss0[m] = s;
    }
    if (blockIdx.x == 0) { float* lbv = (float*)(a.ws + WS_LB); const float* lw = a.in[7];
        for (int c = tid; c < 512; c += NTHR) { const float a0 = lw[c], a1 = lw[512 + c]; lbv[c] = 0.f; lbv[512 + c] = 1.0f / (1.0f + expf(a0 - a1)); } }
}

__device__ __forceinline__ void gmlp_stage_w(LAS unsigned char* lds, const float* Wsp, int g, int tid_) {
    int tid = tid_; asm volatile("" : "+v"(tid));
    LAS unsigned char* WL = lds + 40960;
    __syncthreads();
#pragma unroll
    for (int i = 0; i < 8; ++i) { const int idx = tid + 512 * i, t = idx >> 5, c4 = (idx & 31) * 4;
        const f32x4 v = *(const f32x4*)(Wsp + (size_t)(g * 128 + t) * 128 + c4);
        v2u o; o.x = pkbf(c4 <= t ? v.x : 0.f, c4 + 1 <= t ? v.y : 0.f); o.y = pkbf(c4 + 2 <= t ? v.z : 0.f, c4 + 3 <= t ? v.w : 0.f);
        *(LAS v2u*)(WL + t * 272 + c4 * 2) = o; }
}
__device__ __forceinline__ void gmlp_item(LAS unsigned char* lds, int item, const bf16* U, const bf16* V, const float* Wsp, const float* bsp, const float* gv, const float* go, bf16* Y, int tid_) {
    int tid = tid_; asm volatile("" : "+v"(tid));
    const int g = item & 3, row0 = (item >> 2) * 128;
    const LAS unsigned char* WL = lds + 40960;
    const int lane = tid & 63, w = tid >> 6, r = lane & 31, hh = lane >> 5;
    LAS unsigned char* VnT = lds; LAS float* red = (LAS float*)(lds + 34816); LAS float* ssqb = (LAS float*)(lds + 38912);
    __syncthreads();
    {
        const int sp = lane, cr = w;
        const bf16* vp = V + (size_t)(row0 + 2 * sp) * 512 + g * 128 + cr * 16;
        const v4u a0 = *(const v4u*)vp, a1 = *(const v4u*)(vp + 8), b0 = *(const v4u*)(vp + 512), b1 = *(const v4u*)(vp + 520);
        float va[16], vb[16];
#pragma unroll
        for (int j = 0; j < 4; ++j) { va[2 * j] = bf_lo(a0[j]); va[2 * j + 1] = bf_hi(a0[j]); va[8 + 2 * j] = bf_lo(a1[j]); va[9 + 2 * j] = bf_hi(a1[j]);
            vb[2 * j] = bf_lo(b0[j]); vb[2 * j + 1] = bf_hi(b0[j]); vb[8 + 2 * j] = bf_lo(b1[j]); vb[9 + 2 * j] = bf_hi(b1[j]); }
        float sa = 0.f, sb = 0.f;
#pragma unroll
        for (int j = 0; j < 16; ++j) { sa += va[j] * va[j]; sb += vb[j] * vb[j]; }
        red[cr * 128 + 2 * sp] = sa; red[cr * 128 + 2 * sp + 1] = sb;
        __syncthreads();
        float ta = 0.f, tb = 0.f;
#pragma unroll
        for (int k = 0; k < 8; ++k) { ta += red[k * 128 + 2 * sp]; tb += red[k * 128 + 2 * sp + 1]; }
        const float ra = rsqrtf(ta * (1.0f / 128.0f) + EPS), rb = rsqrtf(tb * (1.0f / 128.0f) + EPS);
#pragma unroll
        for (int j = 0; j < 16; ++j) { const int c = cr * 16 + j; const float gw = gv[g * 128 + c];
            *(LAS unsigned*)(VnT + c * 272 + sp * 4) = pkbf(va[j] * ra * gw, vb[j] * rb * gw); }
    }
    __syncthreads();
    const int cb = w >> 1;
    f32x16 acc[2]; float yv[2][16];
#pragma unroll
    for (int x = 0; x < 2; ++x) {
        const int tb = (w & 1) ? (x == 0 ? 1 : 2) : (x == 0 ? 0 : 3);
        const int t = tb * 32 + r;
#pragma unroll
        for (int q = 0; q < 16; ++q) acc[x][q] = 0.f;
        const int nks = (tb + 1) * 2;
        for (int ks = 0; ks < nks; ++ks) {
            const bf16x8 af = *(const LAS bf16x8*)(VnT + (cb * 32 + r) * 272 + (ks * 16 + 8 * hh) * 2);
            const bf16x8 bw = *(const LAS bf16x8*)(WL + t * 272 + (ks * 16 + 8 * hh) * 2);
            acc[x] = __builtin_amdgcn_mfma_f32_32x32x16_bf16(af, bw, acc[x], 0, 0, 0);
        }
        const float bias = bsp[g * 128 + t]; float ssq = 0.f;
#pragma unroll
        for (int i = 0; i < 4; ++i) { const int c = cb * 32 + 8 * i + 4 * hh;
            const v2u uw = *(const v2u*)(U + (size_t)(row0 + t) * 512 + g * 128 + c);
            const float u0 = bf_lo(uw.x), u1 = bf_hi(uw.x), u2 = bf_lo(uw.y), u3 = bf_hi(uw.y);
            yv[x][4 * i + 0] = u0 * (acc[x][4 * i + 0] + bias); yv[x][4 * i + 1] = u1 * (acc[x][4 * i + 1] + bias);
            yv[x][4 * i + 2] = u2 * (acc[x][4 * i + 2] + bias); yv[x][4 * i + 3] = u3 * (acc[x][4 * i + 3] + bias);
#pragma unroll
            for (int j = 0; j < 4; ++j) ssq += yv[x][4 * i + j] * yv[x][4 * i + j]; }
        ssq += __shfl_xor(ssq, 32);
        if (hh == 0) ssqb[cb * 128 + t] = ssq;
    }
    __syncthreads();
#pragma unroll
    for (int x = 0; x < 2; ++x) {
        const int tb = (w & 1) ? (x == 0 ? 1 : 2) : (x == 0 ? 0 : 3);
        const int t = tb * 32 + r;
        const float tot = (ssqb[t] + ssqb[128 + t]) + (ssqb[256 + t] + ssqb[384 + t]);
        const float rs = rsqrtf(tot * (1.0f / 128.0f) + EPS);
#pragma unroll
        for (int i = 0; i < 4; ++i) { const int c = cb * 32 + 8 * i + 4 * hh; const f32x4 gw = *(const f32x4*)(go + g * 128 + c);
            v2u o; o.x = pkbf(yv[x][4 * i] * rs * gw[0], yv[x][4 * i + 1] * rs * gw[1]); o.y = pkbf(yv[x][4 * i + 2] * rs * gw[2], yv[x][4 * i + 3] * rs * gw[3]);
            *(v2u*)(Y + (size_t)(row0 + t) * 1024 + g * 128 + c) = o; }
    }
}

template <bool OUT>
__device__ __forceinline__ void hgrn_item(LAS unsigned char* lds, int item, const bf16* Q, const float* LF, const bf16* I, const bf16* G, const float* gbo, float* SLOC, float* DTOT, bf16* Y, int tid_) {
    int tid = tid_; asm volatile("" : "+v"(tid));
    const int sc = item & 15, bh = item >> 4, b = bh >> 2, h = bh & 3;
    const int rowbase = b * SEQ + sc * 256;
    const int lane = tid & 63, w = tid >> 6, r = lane & 31, hh = lane >> 5;
    LAS unsigned char* Q1s = lds; LAS unsigned char* K1s = lds + 17408; LAS unsigned char* K2T = lds + 34816; LAS unsigned char* VT = lds + 53248;
    LAS unsigned char* ST = lds + 71680; LAS unsigned char* Ps = lds + 106496;
    LAS float* totb = (LAS float*)(lds + 115712); LAS float* dl = (LAS float*)(lds + 117760); LAS float* ssqb = (LAS float*)(lds + 118272);
    const int kb = w >> 1, vb0 = (w & 1) * 2;
    const int vb = w >> 1, tb = w & 1;
    f32x16 S[2];
#pragma unroll
    for (int x = 0; x < 2; ++x)
#pragma unroll
        for (int q = 0; q < 16; ++q) S[x][q] = 0.f;
    __syncthreads();
    if (OUT) {
        for (int m = 0; m < sc; ++m) {
            const float* dt = DTOT + (size_t)(bh * 16 + m) * 128; const float* sl = SLOC + (size_t)(bh * 16 + m) * 16384;
#pragma unroll
            for (int i = 0; i < 4; ++i) { const int k0 = kb * 32 + 8 * i + 4 * hh; const f32x4 d4 = *(const f32x4*)(dt + k0);
#pragma unroll
                for (int x = 0; x < 2; ++x)
#pragma unroll
                    for (int j = 0; j < 4; ++j) S[x][4 * i + j] = d4[j] * S[x][4 * i + j] + sl[(size_t)(k0 + j) * 128 + (vb0 + x) * 32 + r]; }
        }
#pragma unroll
        for (int x = 0; x < 2; ++x)
#pragma unroll
            for (int i = 0; i < 4; ++i) { v2u o; o.x = pkbf(S[x][4 * i], S[x][4 * i + 1]); o.y = pkbf(S[x][4 * i + 2], S[x][4 * i + 3]);
                *(LAS v2u*)(ST + ((vb0 + x) * 32 + r) * 272 + (kb * 32 + 8 * i + 4 * hh) * 2) = o; }
    }
    const int ch = tid & 127, part = tid >> 7;
    float btot = 0.f;
    float nlf[16]; unsigned short niv[16], nqv[16];
    {
        const size_t e0 = (size_t)(rowbase + part * 16) * 512 + h * 128 + ch;
#pragma unroll
        for (int i = 0; i < 16; ++i) { nlf[i] = LF[e0 + (size_t)i * 512]; niv[i] = I[e0 + (size_t)i * 512]; if (OUT) nqv[i] = Q[e0 + (size_t)i * 512]; }
    }
    for (int jc = 0; jc < 4; ++jc) {
        const int row0 = rowbase + jc * 64;
        float cs[16], lfv[16]; unsigned short iv[16], qv[16];
#pragma unroll
        for (int i = 0; i < 16; ++i) { cs[i] = nlf[i]; lfv[i] = nlf[i]; iv[i] = niv[i]; if (OUT) qv[i] = nqv[i]; }
#pragma unroll
        for (int i = 1; i < 16; ++i) cs[i] += cs[i - 1];
        totb[part * 128 + ch] = cs[15];
        __syncthreads();
        const float t0 = totb[ch], t1 = totb[128 + ch], t2 = totb[256 + ch], t3 = totb[384 + ch];
        const float off = (part > 0 ? t0 : 0.f) + (part > 1 ? t1 : 0.f) + (part > 2 ? t2 : 0.f);
        const float bl = (t0 + t1) + (t2 + t3);
        {
            unsigned k2w[8], vw[8];
#pragma unroll
            for (int i = 0; i < 16; i += 2) {
                const float b0 = off + cs[i], b1 = off + cs[i + 1];
                const float k0 = 1.0f - __expf(lfv[i]), k1 = 1.0f - __expf(lfv[i + 1]);
                k2w[i >> 1] = pkbf(k0 * __expf(bl - b0), k1 * __expf(bl - b1));
                vw[i >> 1] = (unsigned)iv[i] | ((unsigned)iv[i + 1] << 16);
                if (OUT) {
                    const float q0 = bf1(qv[i]) * __expf(b0), q1 = bf1(qv[i + 1]) * __expf(b1);
                    const float c0 = k0 * __expf(fminf(-b0, 80.f)), c1 = k1 * __expf(fminf(-b1, 80.f));
                    *(LAS bf16*)(Q1s + (part * 16 + i) * 272 + ch * 2) = tobf(q0); *(LAS bf16*)(Q1s + (part * 16 + i + 1) * 272 + ch * 2) = tobf(q1);
                    *(LAS bf16*)(K1s + (part * 16 + i) * 272 + ch * 2) = tobf(c0); *(LAS bf16*)(K1s + (part * 16 + i + 1) * 272 + ch * 2) = tobf(c1);
                }
            }
            *(LAS v4u*)(K2T + ch * 144 + part * 32) = (v4u){k2w[0], k2w[1], k2w[2], k2w[3]}; *(LAS v4u*)(K2T + ch * 144 + part * 32 + 16) = (v4u){k2w[4], k2w[5], k2w[6], k2w[7]};
            *(LAS v4u*)(VT + ch * 144 + part * 32) = (v4u){vw[0], vw[1], vw[2], vw[3]}; *(LAS v4u*)(VT + ch * 144 + part * 32 + 16) = (v4u){vw[4], vw[5], vw[6], vw[7]};
            if (part == 0) { dl[ch] = __expf(bl); btot += bl; }
        }
        __syncthreads();
        if (jc < 3) {
            const size_t e0 = (size_t)(row0 + 64 + part * 16) * 512 + h * 128 + ch;
#pragma unroll
            for (int i = 0; i < 16; ++i) { nlf[i] = LF[e0 + (size_t)i * 512]; niv[i] = I[e0 + (size_t)i * 512]; if (OUT) nqv[i] = Q[e0 + (size_t)i * 512]; }
        }
        f32x16 accO;
#pragma unroll
        for (int q = 0; q < 16; ++q) accO[q] = 0.f;
        if (OUT) {
            if (w < 3) {
                const int sb = (w == 2) ? 1 : 0, tbs = (w == 0) ? 0 : 1;
                f32x16 sa;
#pragma unroll
                for (int q = 0; q < 16; ++q) sa[q] = 0.f;
#pragma unroll
                for (int ks = 0; ks < 8; ++ks) {
                    const bf16x8 af = *(const LAS bf16x8*)(K1s + (sb * 32 + r) * 272 + (ks * 16 + 8 * hh) * 2);
                    const bf16x8 bfr = *(const LAS bf16x8*)(Q1s + (tbs * 32 + r) * 272 + (ks * 16 + 8 * hh) * 2);
                    sa = __builtin_amdgcn_mfma_f32_32x32x16_bf16(af, bfr, sa, 0, 0, 0);
                }
                const int t = tbs * 32 + r;
#pragma unroll
                for (int i = 0; i < 4; ++i) { const int s0 = sb * 32 + 8 * i + 4 * hh;
                    const float p0 = (s0 + 0 <= t) ? sa[4 * i + 0] : 0.f, p1 = (s0 + 1 <= t) ? sa[4 * i + 1] : 0.f, p2 = (s0 + 2 <= t) ? sa[4 * i + 2] : 0.f, p3 = (s0 + 3 <= t) ? sa[4 * i + 3] : 0.f;
                    v2u o; o.x = pkbf(p0, p1); o.y = pkbf(p2, p3);
                    *(LAS v2u*)(Ps + t * 144 + s0 * 2) = o; }
            }
#pragma unroll
            for (int ks = 0; ks < 8; ++ks) {
                const bf16x8 af = *(const LAS bf16x8*)(ST + (vb * 32 + r) * 272 + (ks * 16 + 8 * hh) * 2);
                const bf16x8 bfr = *(const LAS bf16x8*)(Q1s + (tb * 32 + r) * 272 + (ks * 16 + 8 * hh) * 2);
                accO = __builtin_amdgcn_mfma_f32_32x32x16_bf16(af, bfr, accO, 0, 0, 0);
            }
            __syncthreads();
            const int nks = (tb + 1) * 2;
            for (int ks = 0; ks < nks; ++ks) {
                const bf16x8 af = *(const LAS bf16x8*)(VT + (vb * 32 + r) * 144 + (ks * 16 + 8 * hh) * 2);
                const bf16x8 bfr = *(const LAS bf16x8*)(Ps + (tb * 32 + r) * 144 + (ks * 16 + 8 * hh) * 2);
                accO = __builtin_amdgcn_mfma_f32_32x32x16_bf16(af, bfr, accO, 0, 0, 0);
            }
        }
        if (!OUT || jc < 3) {
#pragma unroll
            for (int i = 0; i < 4; ++i) { const f32x4 d4 = *(const LAS f32x4*)(dl + kb * 32 + 8 * i + 4 * hh);
#pragma unroll
                for (int x = 0; x < 2; ++x)
#pragma unroll
                    for (int j = 0; j < 4; ++j) S[x][4 * i + j] *= d4[j]; }
#pragma unroll
            for (int ks = 0; ks < 4; ++ks) {
                const bf16x8 af = *(const LAS bf16x8*)(K2T + (kb * 32 + r) * 144 + (ks * 16 + 8 * hh) * 2);
#pragma unroll
                for (int x = 0; x < 2; ++x) {
                    const bf16x8 bfr = *(const LAS bf16x8*)(VT + ((vb0 + x) * 32 + r) * 144 + (ks * 16 + 8 * hh) * 2);
                    S[x] = __builtin_amdgcn_mfma_f32_32x32x16_bf16(af, bfr, S[x], 0, 0, 0);
                }
            }
            if (OUT) {
#pragma unroll
                for (int x = 0; x < 2; ++x)
#pragma unroll
                    for (int i = 0; i < 4; ++i) { v2u o; o.x = pkbf(S[x][4 * i], S[x][4 * i + 1]); o.y = pkbf(S[x][4 * i + 2], S[x][4 * i + 3]);
                        *(LAS v2u*)(ST + ((vb0 + x) * 32 + r) * 272 + (kb * 32 + 8 * i + 4 * hh) * 2) = o; }
            }
        }
        if (OUT) {
            float ssq = 0.f;
#pragma unroll
            for (int q = 0; q < 16; ++q) ssq += accO[q] * accO[q];
            ssq += __shfl_xor(ssq, 32);
            if (hh == 0) ssqb[vb * 64 + tb * 32 + r] = ssq;
        }
        __syncthreads();
        if (OUT) {
            const int tl = tb * 32 + r;
            const float tot = (ssqb[tl] + ssqb[64 + tl]) + (ssqb[128 + tl] + ssqb[192 + tl]);
            const float rs = rsqrtf(tot * (1.0f / 128.0f) + EPS);
#pragma unroll
            for (int i = 0; i < 4; ++i) { const int v0 = vb * 32 + 8 * i + 4 * hh;
                const v2u gw = *(const v2u*)(G + (size_t)(row0 + tl) * 512 + h * 128 + v0); const f32x4 nw = *(const f32x4*)(gbo + h * 128 + v0);
                v2u o; o.x = pkbf(accO[4 * i] * rs * nw[0] * bf_lo(gw.x), accO[4 * i + 1] * rs * nw[1] * bf_hi(gw.x));
                o.y = pkbf(accO[4 * i + 2] * rs * nw[2] * bf_lo(gw.y), accO[4 * i + 3] * rs * nw[3] * bf_hi(gw.y));
                *(v2u*)(Y + (size_t)(row0 + tl) * 1024 + 512 + h * 128 + v0) = o; }
        }
    }
    if (!OUT) {
        float* sl = SLOC + (size_t)(bh * 16 + sc) * 16384;
#pragma unroll
        for (int x = 0; x < 2; ++x)
#pragma unroll
            for (int q = 0; q < 16; ++q) { const int k = kb * 32 + (q & 3) + 8 * (q >> 2) + 4 * hh; sl[(size_t)k * 128 + (vb0 + x) * 32 + r] = S[x][q]; }
        if (part == 0) DTOT[(size_t)(bh * 16 + sc) * 128 + ch] = __expf(btot);
    }
}

#define RLX_AGENT __ATOMIC_RELAXED, __HIP_MEMORY_SCOPE_AGENT
#define XB_TMO      128
#define XB_XCNT(j)  (256  + 64 * (j))
#define XB_XSUB(j)  (1280 + 64 * (j))
#define XB_XGEN(j)  (2304 + 64 * (j))
#define XB_TOP      3328
#define XB_TOPGEN   3392
#define XCD_BAR_WORDS 3456
#define XB_SPIN_CAP (1u << 18)

__device__ __forceinline__ unsigned xb_ld(unsigned* p)              { return __hip_atomic_load(p, __ATOMIC_RELAXED, __HIP_MEMORY_SCOPE_AGENT); }
__device__ __forceinline__ unsigned xb_add(unsigned* p, unsigned v) { return __hip_atomic_fetch_add(p, v, __ATOMIC_RELAXED, __HIP_MEMORY_SCOPE_AGENT); }
__device__ __forceinline__ unsigned xb_xcc_id() { return (unsigned)__builtin_amdgcn_s_getreg((3 << 11) | 20) & 0xFu; }
#define XB_SPIN(cond, bar) do { unsigned _sp = 0; while (cond) { __builtin_amdgcn_s_sleep(1); \
    if ((++_sp & 255u) == 0u) { if (xb_ld(&(bar)[XB_TMO])) break; if (_sp > XB_SPIN_CAP) { atomicAdd(&(bar)[XB_TMO], 1u); break; } } } } while (0)

struct XcdBarrier {
    unsigned* bar; unsigned x;
    volatile LAS unsigned* st;
};

__device__ __forceinline__ XcdBarrier xcd_barrier_post(unsigned* bar, volatile LAS unsigned* st) {
    XcdBarrier b; b.bar = bar; b.x = xb_xcc_id(); b.st = st;
    if (threadIdx.x == 0) (void)xb_add(&bar[XB_XCNT(b.x)], 1u);
    return b;
}
__device__ __forceinline__ void xcd_barrier_complete(unsigned* bar, unsigned x, unsigned& nloc, unsigned& nx) {
    const unsigned G = gridDim.x * gridDim.y * gridDim.z;
    unsigned sum, cnt, mine, sp = 0u;
    for (;;) {
        sum = 0u; cnt = 0u; mine = 0u;
#pragma unroll
        for (unsigned j = 0; j < 16; ++j) { const unsigned c = xb_ld(&bar[XB_XCNT(j)]); sum += c; cnt += (c > 0u) ? 1u : 0u; mine = (j == x) ? c : mine; }
        if (sum == G) break;
        __builtin_amdgcn_s_sleep(1);
        if ((++sp & 255u) == 0u) { if (xb_ld(&bar[XB_TMO])) break; if (sp > XB_SPIN_CAP) { atomicAdd(&bar[XB_TMO], 1u); break; } }
    }
    nloc = mine > 0u ? mine : 1u; nx = cnt > 0u ? cnt : 1u;
}

__device__ __forceinline__ void xcd_barrier(const XcdBarrier& b) {
    asm volatile("s_waitcnt vmcnt(0)" ::: "memory");
    __syncthreads();
    if (threadIdx.x == 0) {
        unsigned* bar = b.bar;
        __builtin_amdgcn_s_waitcnt(0);
        unsigned nloc = b.st[0], nx = b.st[1];
        if (nloc == 0u) { xcd_barrier_complete(bar, b.x, nloc, nx); b.st[0] = nloc; b.st[1] = nx; }
        const unsigned old = xb_add(&bar[XB_XSUB(b.x)], 1u);
        const unsigned gen = old / nloc;
        if (old + 1u == (gen + 1u) * nloc) {
            __builtin_amdgcn_fence(__ATOMIC_RELEASE, "agent");
            asm volatile("s_waitcnt vmcnt(0)" ::: "memory");
            const unsigned og = xb_add(&bar[XB_TOP], 1u);
            const unsigned tg = og / nx;
            if (og + 1u == (tg + 1u) * nx) xb_add(&bar[XB_TOPGEN], 1u);
            else XB_SPIN(xb_ld(&bar[XB_TOPGEN]) == tg, bar);
            __builtin_amdgcn_fence(__ATOMIC_ACQUIRE, "agent");
            xb_add(&bar[XB_XGEN(b.x)], 1u);
            asm volatile("s_waitcnt vmcnt(0)" ::: "memory");
        } else {
            XB_SPIN(xb_ld(&bar[XB_XGEN(b.x)]) == gen, bar);
            __builtin_amdgcn_fence(__ATOMIC_ACQUIRE, "agent");
            asm volatile("s_waitcnt vmcnt(0)" ::: "memory");
        }
    }
    __syncthreads();
}

__global__ void __launch_bounds__(NTHR, 2) fwd_megakernel(Args a) {
    extern __shared__ __attribute__((aligned(16))) unsigned char lds_raw[];
    LAS unsigned char* lds = (LAS unsigned char*)lds_raw;
    cg::grid_group grid = cg::this_grid();
    const int tid = threadIdx.x, G_ = gridDim.x;
    const int lo = a.ph_lo, hi = a.ph_hi;
    unsigned char* ws = a.ws;
#define IN(k) (lo <= (k) && (k) < hi)
#define SEAM(k) do { if (IN(k) && IN((k) + 1)) { for (int rs_ = 0; rs_ < REP_SYNC; ++rs_) { xcd_barrier(bar); } } } while (0)
    volatile LAS unsigned* bst = (volatile LAS unsigned*)(lds + 131072 + 256);
    if (tid < 4) bst[tid] = 0u;
    __syncthreads();
    XcdBarrier bar = xcd_barrier_post((unsigned*)(ws + WS_BAR), bst);
    if (a.ph_lo < 0) grid.sync();
    float* rowss = (float*)(ws + WS_SS);
    bf16* XB = (bf16*)(ws + WS_XB); bf16* HB = (bf16*)(ws + WS_H);
    bf16* Ub = (bf16*)(ws + WS_U); bf16* Vb = (bf16*)(ws + WS_V); bf16* Qb = (bf16*)(ws + WS_Q); float* LFb = (float*)(ws + WS_LF); bf16* Ib = (bf16*)(ws + WS_I); bf16* Gb = (bf16*)(ws + WS_G);
    bf16* Yb = (bf16*)(ws + WS_Y); float* SLOC = (float*)(ws + WS_SLOC); float* DTOT = (float*)(ws + WS_DTOT);

#ifndef SKIP_P0
    if (IN(0)) { for (int rp_ = 0; rp_ < REP_P0; ++rp_) { p0_prologue(a, lds, tid); __syncthreads(); } }
#endif
    SEAM(0);
    for (int l = 0; l < 2; ++l) {
        const int p = 1 + 6 * l;
        unsigned char* wl = ws + WS_W + (size_t)l * W_LAYER;
#ifndef SKIP_G1
        if (IN(p)) for (int rg_ = 0; rg_ < REP_G13; ++rg_) {
            pg8::Gemm g{XB, (const bf16*)(wl + W_IN), M, DIN, D}; pg8::StaticOrder S; S.init(M, DIN, G_, (int)blockIdx.x);
            pg8::EpiIn E{rowss + (size_t)(2 * l) * M, (const float*)(ws + WS_LB) + l * 512, Ub, Vb, Qb, LFb, Ib, Gb};
            pg8::gemm_phase<pg8::EpiIn, pg8::StaticOrder, true, true>(lds, g, S, E);
        }
#endif
        SEAM(p);
#ifndef SKIP_MIX1
        if (IN(p + 1)) for (int rm_ = 0; rm_ < REP_MIX; ++rm_) {
            for (int it = blockIdx.x; it < 256; it += G_)
                hgrn_item<false>(lds, it, Qb, LFb, Ib, Gb, a.in[8] + l * 512, SLOC, DTOT, Yb, tid);
            int gl = -1;
            for (int it = blockIdx.x; it < 512; it += G_) {
                if ((it & 3) != gl) { gl = it & 3; gmlp_stage_w(lds, a.in[3] + (size_t)l * 4 * 128 * 128, gl, tid); }
                gmlp_item(lds, it, Ub, Vb, a.in[3] + (size_t)l * 4 * 128 * 128, a.in[4] + l * 512, a.in[5] + l * 512, a.in[6] + l * 512, Yb, tid);
            }
            __syncthreads();
        }
#endif
        SEAM(p + 1);
#ifndef SKIP_MIX2
        if (IN(p + 2)) for (int rm_ = 0; rm_ < REP_MIX; ++rm_) {
            for (int it = blockIdx.x; it < 256; it += G_)
                hgrn_item<true>(lds, it, Qb, LFb, Ib, Gb, a.in[8] + l * 512, SLOC, DTOT, Yb, tid);
            __syncthreads();
        }
#endif
        SEAM(p + 2);
#ifndef SKIP_G2
        if (IN(p + 3)) {
            pg8::Gemm g{Yb, (const bf16*)(wl + W_OUT), M, D, D}; pg8::StaticOrder S; S.init(M, D, G_, (int)blockIdx.x);
            pg8::EpiRes E{l == 0 ? a.in[0] : a.out, a.out, XB, rowss + (size_t)(2 * l + 1) * M};
            pg8::gemm_phase<pg8::EpiRes, pg8::StaticOrder, false, true>(lds, g, S, E);
        }
#endif
        SEAM(p + 3);
#ifndef SKIP_G3
        if (IN(p + 4)) for (int rg_ = 0; rg_ < REP_G13; ++rg_) {
            pg8::Gemm g{XB, (const bf16*)(wl + W_UP), M, DFF, D}; pg8::StaticOrder S; S.init(M, DFF, G_, (int)blockIdx.x);
            pg8::EpiSq E{rowss + (size_t)(2 * l + 1) * M, HB, DFF};
            pg8::gemm_phase<pg8::EpiSq, pg8::StaticOrder, true, true>(lds, g, S, E);
        }
#endif
        SEAM(p + 4);
#ifndef SKIP_G4
        if (IN(p + 5)) {
            pg8::Gemm g{HB, (const bf16*)(wl + W_DOWN), M, D, DFF}; pg8::StaticOrder S; S.init(M, D, G_, (int)blockIdx.x);
            pg8::EpiRes E{a.out, a.out, XB, rowss + (size_t)(2 * l + 2) * M};
            pg8::gemm_phase<pg8::EpiRes, pg8::StaticOrder, false, true>(lds, g, S, E);
        }
#endif
        SEAM(p + 5);
    }
    if (IN(13)) {
        const int lane = tid & 63, wave = tid >> 6; const float* ssf = rowss + (size_t)4 * M; const f32x4* nf = (const f32x4*)a.in[13] + lane;
        for (int m = blockIdx.x * NWAVES + wave; m < M; m += G_ * NWAVES) {
            const float rs = rsqrtf(ssf[m] * (1.0f / 1024.0f) + EPS);
            f32x4* xr = (f32x4*)(a.out + (size_t)m * D) + lane;
#pragma unroll
            for (int j = 0; j < 4; ++j) { const f32x4 v = xr[64 * j]; xr[64 * j] = v * rs * nf[64 * j]; }
        }
    }
#undef IN
#undef SEAM
}

extern "C" void kernel_launch(void* const* d_in, const int* in_sizes, int n_in, void* d_out, int out_size, void* d_ws, size_t ws_size, hipStream_t stream) {
    static int grid = 0;
    if (grid == 0) {
        if (n_in != 14 || in_sizes[0] != M * D || out_size != M * D || ws_size < WS_END) { fprintf(stderr, "kernel_launch: unexpected shapes (n_in %d, in0 %d, out %d, ws %zu)\n", n_in, n_in > 0 ? in_sizes[0] : -1, out_size, ws_size); grid = -1; return; }
        int dev = 0, cus = 0, per_cu = 0;
        if (hipGetDevice(&dev) != hipSuccess || hipDeviceGetAttribute(&cus, hipDeviceAttributeMultiprocessorCount, dev) != hipSuccess) { grid = -1; return; }
        if (hipFuncSetAttribute((const void*)fwd_megakernel, hipFuncAttributeMaxDynamicSharedMemorySize, LDS_BYTES) != hipSuccess) { fprintf(stderr, "kernel_launch: hipFuncSetAttribute failed\n"); grid = -1; return; }
        if (hipOccupancyMaxActiveBlocksPerMultiprocessor(&per_cu, (const void*)fwd_megakernel, NTHR, LDS_BYTES) != hipSuccess || per_cu < 1) { fprintf(stderr, "kernel_launch: occupancy query reports %d blocks per CU\n", per_cu); (void)hipGetLastError(); grid = -1; return; }
        grid = cus;
    }
    if (grid < 0) return;
    (void)hipMemsetAsync((char*)d_ws + WS_SS, 0, CTL_ZERO_BYTES, stream);
    Args a{};
    for (int i = 0; i < 14; ++i) a.in[i] = (const float*)d_in[i];
    a.out = (float*)d_out; a.ws = (unsigned char*)d_ws;
#if MK_N_LAUNCHES == 1
    a.ph_lo = 0; a.ph_hi = NPHASE;
    void* args[] = {&a};
    hipError_t e = hipLaunchCooperativeKernel((const void*)fwd_megakernel, dim3(grid), dim3(NTHR), args, LDS_BYTES, stream);
    if (e != hipSuccess) fprintf(stderr, "kernel_launch: cooperative launch failed: %s (grid %d)\n", hipGetErrorString(e), grid);
#else
    for (int ph = 0; ph < NPHASE; ++ph) { a.ph_lo = ph; a.ph_hi = ph + 1; hipLaunchKernelGGL(fwd_megakernel, dim3(grid), dim3(NTHR), LDS_BYTES, stream, a); }
#endif
}
```
